# Optimizing an MI355X kernel written in HIP

```python
import math
import jax, jax.numpy as jnp
from jax import lax
import numpy as np

D_MODEL = 1024
BATCH = 32
SEQ = 2048
DEPTH = 4

CHUNK = 64
RET_HEADS = 4
RET_DK = 128
RET_DV = 256
CA_HEADS = 8
CA_DH = 64
CA_LEFT_CHUNKS = 8
REL_CLIP = 256
DA_HEADS = 4
DA_DH = 64
Q_BLOCK = 128
FFN_HIDDEN = -(-8 * D_MODEL // (3 * 256)) * 256
ROPE_THETA = 10000.0
LN_EPS = 1e-5
NEG_INF = -1e30
DEEPNORM_ALPHA = (2.0 * DEPTH) ** 0.25
DEEPNORM_BETA = (8.0 * DEPTH) ** -0.25
N_BRANCHES = 3

RET_QK_W = RET_HEADS * RET_DK
RET_V_W = RET_HEADS * RET_DV
CA_W = CA_HEADS * CA_DH
DA_QK_W = 2 * DA_HEADS * DA_DH
DA_V_W = DA_HEADS * 2 * DA_DH
IN_WIDTHS = (RET_QK_W, RET_QK_W, RET_V_W, RET_V_W, CA_W, CA_W, CA_W, DA_QK_W, DA_QK_W, DA_V_W, N_BRANCHES * D_MODEL)
IN_IS_VALUE = (False, False, True, False, False, False, True, False, False, True, False)
IN_TOTAL = sum(IN_WIDTHS)

kernel_name = "hybrid_retention_chunkattn_diffattn_deepnorm"


def _layer_norm(x, g, b):
    xf = x.astype(jnp.float32)
    mu = jnp.mean(xf, axis=-1, keepdims=True)
    var = jnp.mean(jnp.square(xf - mu), axis=-1, keepdims=True)
    return ((xf - mu) * lax.rsqrt(var + LN_EPS) * g.astype(jnp.float32) + b.astype(jnp.float32)).astype(x.dtype)


def _rms_norm(x, g):
    xf = x.astype(jnp.float32)
    y = xf * lax.rsqrt(jnp.mean(xf * xf, axis=-1, keepdims=True) + LN_EPS) * g.astype(jnp.float32)
    return y.astype(x.dtype)


def _rotary(x):
    S, d = x.shape[1], x.shape[-1]
    inv_freq = ROPE_THETA ** (-jnp.arange(0, d, 2, dtype=jnp.float32) / d)
    ang = jnp.arange(S, dtype=jnp.float32)[:, None] * inv_freq[None, :]
    cos = jnp.cos(ang)[None, :, None, :].astype(x.dtype)
    sin = jnp.sin(ang)[None, :, None, :].astype(x.dtype)
    x1, x2 = x[..., : d // 2], x[..., d // 2:]
    return jnp.concatenate([x1 * cos - x2 * sin, x2 * cos + x1 * sin], axis=-1)


def _retention(q, k, v, gate, norm_g):
    B, S, H, dk = q.shape
    dv = v.shape[-1]
    nc = S // CHUNK
    q = _rotary(q)
    k = _rotary(k) * (dk ** -0.5)
    log_gamma = jnp.log1p(-jnp.exp2(-5.0 - jnp.arange(H, dtype=jnp.float32)))
    pos = jnp.arange(CHUNK, dtype=jnp.float32)
    intra_decay = jnp.exp(log_gamma[:, None, None] * jnp.abs(pos[:, None] - pos[None, :]))
    q_decay = jnp.exp(log_gamma[None, :] * (pos[:, None] + 1.0))
    k_decay = jnp.exp(log_gamma[None, :] * (CHUNK - 1.0 - pos[:, None]))
    chunk_decay = jnp.exp(log_gamma * CHUNK)

    qc = q.reshape(B, nc, CHUNK, H, dk)
    kc = k.reshape(B, nc, CHUNK, H, dk)
    vc = v.reshape(B, nc, CHUNK, H, dv)
    scores = jnp.einsum('bcnhd,bcmhd->bchnm', qc, kc) * intra_decay.astype(q.dtype)
    o_intra = jnp.einsum('bchnm,bcmhe->bcnhe', scores, vc)

    def step(state, xs):
        q_i, k_i, v_i = xs
        o = jnp.einsum('bnhd,bhde->bnhe', q_i.astype(jnp.float32) * q_decay[None, :, :, None], state)
        kv = jnp.einsum('bmhd,bmhe->bhde', k_i.astype(jnp.float32) * k_decay[None, :, :, None], v_i.astype(jnp.float32))
        state = state * chunk_decay[None, :, None, None] + kv
        return state, o

    state0 = jnp.zeros((B, H, dk, dv), jnp.float32)
    _, o_inter = lax.scan(step, state0, (jnp.swapaxes(qc, 0, 1), jnp.swapaxes(kc, 0, 1), jnp.swapaxes(vc, 0, 1)))
    o = (o_intra.astype(jnp.float32) + jnp.swapaxes(o_inter, 0, 1)).astype(v.dtype)
    o = _rms_norm(o, norm_g).reshape(B, S, H * dv)
    return jax.nn.silu(gate) * o


def _chunk_attention(q, k, v, rel_bias):
    B, S, H, d = q.shape
    nc = S // CHUNK
    pad = CA_LEFT_CHUNKS * CHUNK
    band = pad + CHUNK
    k_pad = jnp.pad(k, ((0, 0), (pad, 0), (0, 0), (0, 0)))
    v_pad = jnp.pad(v, ((0, 0), (pad, 0), (0, 0), (0, 0)))
    qpos = jnp.arange(CHUNK)
    kpos = jnp.arange(band)
    rel = qpos[:, None] + pad - kpos[None, :]
    idx = jnp.clip(rel, -REL_CLIP, REL_CLIP) + REL_CLIP
    bias = rel_bias[:, idx].astype(jnp.float32)
    q = q * (d ** -0.5)

    def one_chunk(i):
        start = i * CHUNK
        q_i = lax.dynamic_slice_in_dim(q, start, CHUNK, axis=1)
        k_i = lax.dynamic_slice_in_dim(k_pad, start, band, axis=1)
        v_i = lax.dynamic_slice_in_dim(v_pad, start, band, axis=1)
        s = jnp.einsum('bqhd,bkhd->bhqk', q_i, k_i).astype(jnp.float32) + bias[None]
        valid = (start - pad + kpos) >= 0
        s = jnp.where(valid[None, None, None, :], s, NEG_INF)
        p = jax.nn.softmax(s, axis=-1).astype(v.dtype)
        return jnp.einsum('bhqk,bkhd->bqhd', p, v_i)

    o = lax.map(one_chunk, jnp.arange(nc))
    return jnp.transpose(o, (1, 0, 2, 3, 4)).reshape(B, S, H * d)


def _diff_attention(q, k, v, lam, lambda_init, norm_g):
    B, S, H2, d = q.shape
    H = H2 // 2
    q = _rotary(q) * (d ** -0.5)
    k = _rotary(k)
    nb = S // Q_BLOCK
    key_chunk = jnp.arange(S) // CHUNK

    def one_block(i):
        start = i * Q_BLOCK
        q_i = lax.dynamic_slice_in_dim(q, start, Q_BLOCK, axis=1)
        s = jnp.einsum('bqgd,bkgd->bgqk', q_i, k).astype(jnp.float32)
        query_chunk = (start + jnp.arange(Q_BLOCK)) // CHUNK
        allowed = key_chunk[None, :] <= query_chunk[:, None]
        s = jnp.where(allowed[None, None], s, NEG_INF)
        p = jax.nn.softmax(s, axis=-1).reshape(B, H, 2, Q_BLOCK, S)
        p = p[:, :, 0] - lam * p[:, :, 1]
        return jnp.einsum('bhqk,bkhe->bqhe', p.astype(v.dtype), v)

    o = lax.map(one_block, jnp.arange(nb))
    o = jnp.transpose(o, (1, 0, 2, 3, 4)).reshape(B, S, H, 2 * d)
    o = _rms_norm(o, norm_g) * (1.0 - lambda_init)
    return o.reshape(B, S, H * 2 * d)


def setup_inputs(seed: int = 0) -> dict:
    key = jax.random.key(seed)
    ks = jax.random.split(key, 24)

    def nrm(k, shape, scale):
        return jax.random.normal(k, shape, jnp.float32) * scale

    beta = DEEPNORM_BETA
    col_scale = jnp.concatenate([
        jnp.full((w,), beta if is_v else 1.0, jnp.float32) for w, is_v in zip(IN_WIDTHS, IN_IS_VALUE)])
    x = nrm(ks[0], (BATCH, SEQ, D_MODEL), 1.0)
    w_in = nrm(ks[1], (DEPTH, D_MODEL, IN_TOTAL), D_MODEL ** -0.5) * col_scale
    ret_norm_g = 1.0 + nrm(ks[2], (DEPTH, RET_DV), 0.02)
    ca_rel_bias = nrm(ks[3], (DEPTH, CA_HEADS, 2 * REL_CLIP + 1), 0.1)
    da_lambda_q1 = nrm(ks[4], (DEPTH, DA_DH), 0.1)
    da_lambda_k1 = nrm(ks[5], (DEPTH, DA_DH), 0.1)
    da_lambda_q2 = nrm(ks[6], (DEPTH, DA_DH), 0.1)
    da_lambda_k2 = nrm(ks[7], (DEPTH, DA_DH), 0.1)
    da_norm_g = 1.0 + nrm(ks[8], (DEPTH, 2 * DA_DH), 0.02)
    w_branch_a = nrm(ks[9], (DEPTH, RET_V_W, D_MODEL), RET_V_W ** -0.5 * beta)
    w_branch_b = nrm(ks[10], (DEPTH, CA_W, D_MODEL), CA_W ** -0.5 * beta)
    w_branch_c = nrm(ks[11], (DEPTH, DA_V_W, D_MODEL), DA_V_W ** -0.5 * beta)
    b_merge = nrm(ks[12], (DEPTH, N_BRANCHES * D_MODEL), 0.1)
    w_out = nrm(ks[13], (DEPTH, D_MODEL, D_MODEL), D_MODEL ** -0.5 * beta)
    ln1_g = 1.0 + nrm(ks[14], (DEPTH, D_MODEL), 0.02)
    ln1_b = nrm(ks[15], (DEPTH, D_MODEL), 0.02)
    w_ffn_in = nrm(ks[16], (DEPTH, D_MODEL, 2 * FFN_HIDDEN), D_MODEL ** -0.5 * beta)
    w_ffn_out = nrm(ks[17], (DEPTH, FFN_HIDDEN, D_MODEL), FFN_HIDDEN ** -0.5 * beta)
    ln2_g = 1.0 + nrm(ks[18], (DEPTH, D_MODEL), 0.02)
    ln2_b = nrm(ks[19], (DEPTH, D_MODEL), 0.02)
    return {
        "x": x, "w_in": w_in, "ret_norm_g": ret_norm_g, "ca_rel_bias": ca_rel_bias,
        "da_lambda_q1": da_lambda_q1, "da_lambda_k1": da_lambda_k1,
        "da_lambda_q2": da_lambda_q2, "da_lambda_k2": da_lambda_k2, "da_norm_g": da_norm_g,
        "w_branch_a": w_branch_a, "w_branch_b": w_branch_b, "w_branch_c": w_branch_c,
        "b_merge": b_merge, "w_out": w_out, "ln1_g": ln1_g, "ln1_b": ln1_b,
        "w_ffn_in": w_ffn_in, "w_ffn_out": w_ffn_out, "ln2_g": ln2_g, "ln2_b": ln2_b,
    }


def reference(x, w_in, ret_norm_g, ca_rel_bias, da_lambda_q1, da_lambda_k1, da_lambda_q2, da_lambda_k2,
              da_norm_g, w_branch_a, w_branch_b, w_branch_c, b_merge, w_out, ln1_g, ln1_b,
              w_ffn_in, w_ffn_out, ln2_g, ln2_b):
    B, S, D = x.shape
    splits = [int(s) for s in np.cumsum(IN_WIDTHS)[:-1]]
    for l in range(DEPTH):
        h = jnp.einsum('bsd,de->bse', x, w_in[l])
        rq, rk, rv, rg, cq, ck, cv, dq, dk, dv, gates = jnp.split(h, splits, axis=-1)

        o_a = _retention(rq.reshape(B, S, RET_HEADS, RET_DK), rk.reshape(B, S, RET_HEADS, RET_DK),
                         rv.reshape(B, S, RET_HEADS, RET_DV), rg, ret_norm_g[l])
        o_b = _chunk_attention(cq.reshape(B, S, CA_HEADS, CA_DH), ck.reshape(B, S, CA_HEADS, CA_DH),
                               cv.reshape(B, S, CA_HEADS, CA_DH), ca_rel_bias[l])
        lambda_init = 0.8 - 0.6 * math.exp(-0.3 * l)
        lam = (jnp.exp(jnp.sum(da_lambda_q1[l].astype(jnp.float32) * da_lambda_k1[l].astype(jnp.float32)))
               - jnp.exp(jnp.sum(da_lambda_q2[l].astype(jnp.float32) * da_lambda_k2[l].astype(jnp.float32)))
               + lambda_init)
        o_c = _diff_attention(dq.reshape(B, S, 2 * DA_HEADS, DA_DH), dk.reshape(B, S, 2 * DA_HEADS, DA_DH),
                              dv.reshape(B, S, DA_HEADS, 2 * DA_DH), lam, lambda_init, da_norm_g[l])

        g = jax.nn.sigmoid(gates + b_merge[l]).reshape(B, S, N_BRANCHES, D)
        merged = (g[:, :, 0] * jnp.einsum('bse,ed->bsd', o_a, w_branch_a[l])
                  + g[:, :, 1] * jnp.einsum('bse,ed->bsd', o_b, w_branch_b[l])
                  + g[:, :, 2] * jnp.einsum('bse,ed->bsd', o_c, w_branch_c[l]))
        mix = jnp.einsum('bsd,de->bse', merged, w_out[l])
        x = _layer_norm(DEEPNORM_ALPHA * x + mix, ln1_g[l], ln1_b[l])

        u = jnp.einsum('bsd,df->bsf', x, w_ffn_in[l])
        u_gate, u_up = jnp.split(u, 2, axis=-1)
        ffn = jnp.einsum('bsf,fd->bsd', jax.nn.silu(u_gate) * u_up, w_ffn_out[l])
        x = _layer_norm(DEEPNORM_ALPHA * x + ffn, ln2_g[l], ln2_b[l])
    return x
```

```cpp
#include <hip/hip_runtime.h>
#include <hip/hip_cooperative_groups.h>
#include <cstdio>
#include <cstdint>
#include <cmath>
namespace cg = cooperative_groups;
namespace pg8 {
#define PG8_LAS __attribute__((address_space(3)))
typedef unsigned short bf16_t;
typedef short bf16x8 __attribute__((ext_vector_type(8)));
typedef float f32x4 __attribute__((ext_vector_type(4)));
typedef unsigned u32x4 __attribute__((ext_vector_type(4)));
constexpr int BM = 256, BK = 64, HALF = 128, HTB = HALF * BK * 2  , STAGE_BYTES = 8 * HTB, NXCD = 8, WGM = 8;

__host__ __device__ __forceinline__ int lds_byte(int r, int c) { const int st = (r >> 4) * 2 + (c >> 5), rr = r & 15, cc = c & 31, ob = rr * 64 + cc * 2; return st * 1024 + (ob ^ (((ob >> 9) & 1) << 5)); }
__host__ __device__ __forceinline__ void stage_rc(int b, int& R, int& C) { const int st = b / 1024, sb = b % 1024, swz = sb ^ (((sb >> 9) & 1) << 5); R = (st >> 1) * 16 + swz / 64; C = (st & 1) * 32 + (swz % 64) / 2; }
__host__ __device__ __forceinline__ int perm32(int rho) { const int n = rho >> 4, i = rho & 15; return 8 * (i >> 2) + 4 * n + (i & 3); }

struct Unit { int pm, pn; };
struct Gemm { const bf16_t* A; const bf16_t* Bt; int M, N, K; };

struct StaticOrder {
    int nM, nN, nwg, G, c;
    __host__ __device__ void init(int M, int N, int G_, int c_) { nM = M / BM; nN = N / BM; nwg = nM * nN; G = G_; c = c_; }
    __host__ __device__ bool next(int i, Unit& u) const {
        const long L = (long)i * G + c; if (L >= nwg) return false;
        int wgid = (int)L; { const int q = nwg / NXCD, r = nwg % NXCD, xcd = wgid % NXCD, off = wgid / NXCD; wgid = (xcd < r ? xcd * (q + 1) : r * (q + 1) + (xcd - r) * q) + off; }
        const int nig = WGM * nN, gid = wgid / nig, fm = gid * WGM, gsz = (nM - fm) < WGM ? (nM - fm) : WGM;
        u.pm = fm + ((wgid % nig) % gsz); u.pn = (wgid % nig) / gsz; return true;
    }
    __device__ __forceinline__ void a_ready(const Unit&) const {}
    __device__ __forceinline__ void done(const Unit&) const {}
};

__device__ __forceinline__ unsigned cvt_pk_bf16(float lo, float hi) { unsigned r; asm volatile("v_cvt_pk_bf16_f32 %0, %1, %2" : "=v"(r) : "v"(lo), "v"(hi)); return r; }
__device__ __forceinline__ void store16(bf16_t* dst, const f32x4 a, const f32x4 b) {
    u32x4 w; w.x = cvt_pk_bf16(a[0], a[1]); w.y = cvt_pk_bf16(a[2], a[3]); w.z = cvt_pk_bf16(b[0], b[1]); w.w = cvt_pk_bf16(b[2], b[3]); *(u32x4*)dst = w;
}
__device__ __forceinline__ float fast_sigmoid(float x) { return __builtin_amdgcn_rcpf(1.0f + __builtin_amdgcn_exp2f(-1.4426950408889634f * x)); }
__device__ __forceinline__ f32x4 silu4(f32x4 v) { f32x4 r; r[0] = v[0] * fast_sigmoid(v[0]); r[1] = v[1] * fast_sigmoid(v[1]); r[2] = v[2] * fast_sigmoid(v[2]); r[3] = v[3] * fast_sigmoid(v[3]); return r; }
__device__ __forceinline__ f32x4 sigm4(f32x4 v) { f32x4 r; r[0] = fast_sigmoid(v[0]); r[1] = fast_sigmoid(v[1]); r[2] = fast_sigmoid(v[2]); r[3] = fast_sigmoid(v[3]); return r; }
__device__ __forceinline__ void unpack8(const u32x4 w, f32x4& a, f32x4& b) {
    a[0] = __uint_as_float(w.x << 16); a[1] = __uint_as_float(w.x & 0xffff0000u); a[2] = __uint_as_float(w.y << 16); a[3] = __uint_as_float(w.y & 0xffff0000u);
    b[0] = __uint_as_float(w.z << 16); b[1] = __uint_as_float(w.z & 0xffff0000u); b[2] = __uint_as_float(w.w << 16); b[3] = __uint_as_float(w.w & 0xffff0000u);
}
constexpr int HWID = 9216;
constexpr float C2F = 0.125f * 1.4426950408889634f;

struct EpiIn {
    static constexpr bool PERM = true, AFTER_DRAIN = false;
    bf16_t* H; const float* bmerge; const float* tabR; const float* tabD;
    __device__ __forceinline__ void operator()(const f32x4 (&acc)[2][2][4][2], const Unit& u, int wr, int wc, int fr, int fq) const {
        const int pn = u.pn; const int row0 = u.pm * BM + wr * 64 + fr; const int q0 = wc * 32 + 8 * fq;
        if (pn < 4) {
            const float sc = pn >= 2 ? 0.08838834764831845f : 1.0f; const int head = q0 >> 6, i0 = q0 & 63;
#pragma unroll
            for (int ai = 0; ai < 2; ++ai)
#pragma unroll
                for (int m = 0; m < 4; ++m) { const int row = row0 + ai * HALF + m * 16; const int pos = row & 2047;
                    const float* cp = tabR + pos * 64 + i0; const float* sp = cp + 2048 * 64;
                    const f32x4 c0 = *(const f32x4*)cp, c1 = *(const f32x4*)(cp + 4), s0 = *(const f32x4*)sp, s1 = *(const f32x4*)(sp + 4);
                    const f32x4 x1a = acc[ai][0][m][0], x1b = acc[ai][0][m][1], x2a = acc[ai][1][m][0], x2b = acc[ai][1][m][1];
                    bf16_t* dst = H + (size_t)row * HWID + pn * 256 + head * 128 + i0;
                    store16(dst, (x1a * c0 - x2a * s0) * sc, (x1b * c1 - x2b * s1) * sc);
                    store16(dst + 64, (x2a * c0 + x1a * s0) * sc, (x2b * c1 + x1b * s1) * sc); asm volatile("" ::: "memory"); }
        } else if (pn >= 18 && pn < 22) {
            const float sc = pn < 20 ? C2F : 1.0f; const int head = q0 >> 5, i0 = q0 & 31;
#pragma unroll
            for (int ai = 0; ai < 2; ++ai)
#pragma unroll
                for (int m = 0; m < 4; ++m) { const int row = row0 + ai * HALF + m * 16; const int pos = row & 2047;
                    const float* cp = tabD + pos * 32 + i0; const float* sp = cp + 2048 * 32;
                    const f32x4 c0 = *(const f32x4*)cp, c1 = *(const f32x4*)(cp + 4), s0 = *(const f32x4*)sp, s1 = *(const f32x4*)(sp + 4);
                    const f32x4 x1a = acc[ai][0][m][0], x1b = acc[ai][0][m][1], x2a = acc[ai][1][m][0], x2b = acc[ai][1][m][1];
                    bf16_t* dst = H + (size_t)row * HWID + pn * 256 + head * 64 + i0;
                    store16(dst, (x1a * c0 - x2a * s0) * sc, (x1b * c1 - x2b * s1) * sc);
                    store16(dst + 32, (x2a * c0 + x1a * s0) * sc, (x2b * c1 + x1b * s1) * sc); asm volatile("" ::: "memory"); }
        } else {
            const int mode = (pn >= 24) ? 2 : ((pn >= 8 && pn < 12) ? 1 : 0); const float sc = (pn == 12 || pn == 13) ? C2F : 1.0f;
#pragma unroll
            for (int bj = 0; bj < 2; ++bj) { const int c = pn * 256 + bj * HALF + q0;
                f32x4 b0 = (f32x4){0.f, 0.f, 0.f, 0.f}, b1 = b0;
                if (mode == 2) { b0 = *(const f32x4*)(bmerge + (c - 6144)); b1 = *(const f32x4*)(bmerge + (c - 6144) + 4); }
#pragma unroll
                for (int ai = 0; ai < 2; ++ai)
#pragma unroll
                    for (int m = 0; m < 4; ++m) { const int row = row0 + ai * HALF + m * 16;
                        f32x4 v0 = acc[ai][bj][m][0], v1 = acc[ai][bj][m][1]; asm volatile("" : "+v"(v0), "+v"(v1));
                        if (mode == 2) { v0 = sigm4(v0 + b0); v1 = sigm4(v1 + b1); } else if (mode == 1) { v0 = silu4(v0); v1 = silu4(v1); } else { v0 = v0 * sc; v1 = v1 * sc; }
                        store16(H + (size_t)row * HWID + c, v0, v1); asm volatile("" ::: "memory"); } }
        }
    }
};
struct EpiBranch {
    static constexpr bool PERM = true, AFTER_DRAIN = false;
    bf16_t* Mg; const bf16_t* H; int gsel; int first;
    __device__ __forceinline__ void operator()(const f32x4 (&acc)[2][2][4][2], const Unit& u, int wr, int wc, int fr, int fq) const {
        const int row0 = u.pm * BM + wr * 64 + fr; const int q0 = wc * 32 + 8 * fq;
#pragma unroll
        for (int ai = 0; ai < 2; ++ai)
#pragma unroll
            for (int m = 0; m < 4; ++m) { const int row = row0 + ai * HALF + m * 16;
#pragma unroll
                for (int bj = 0; bj < 2; ++bj) { const int c = u.pn * 256 + bj * HALF + q0;
                    f32x4 g0, g1; unpack8(*(const u32x4*)(H + (size_t)row * HWID + 6144 + gsel * 1024 + c), g0, g1);
                    f32x4 v0 = g0 * acc[ai][bj][m][0], v1 = g1 * acc[ai][bj][m][1];
                    bf16_t* dst = Mg + (size_t)row * 1024 + c;
                    if (!first) { f32x4 o0, o1; unpack8(*(const u32x4*)dst, o0, o1); v0 = v0 + o0; v1 = v1 + o1; }
                    store16(dst, v0, v1); } asm volatile("" ::: "memory"); }
    }
};
struct EpiResid {
    static constexpr bool PERM = true, AFTER_DRAIN = false;
    const float* resid; float* Y; float alpha;
    __device__ __forceinline__ void operator()(const f32x4 (&acc)[2][2][4][2], const Unit& u, int wr, int wc, int fr, int fq) const {
        const int row0 = u.pm * BM + wr * 64 + fr; const int q0 = wc * 32 + 8 * fq;
#pragma unroll
        for (int ai = 0; ai < 2; ++ai)
#pragma unroll
            for (int m = 0; m < 4; ++m) { const int row = row0 + ai * HALF + m * 16;
#pragma unroll
                for (int bj = 0; bj < 2; ++bj) { const size_t p = (size_t)row * 1024 + u.pn * 256 + bj * HALF + q0;
                    const f32x4 r0 = *(const f32x4*)(resid + p), r1 = *(const f32x4*)(resid + p + 4);
                    *(f32x4*)(Y + p) = r0 * alpha + acc[ai][bj][m][0]; *(f32x4*)(Y + p + 4) = r1 * alpha + acc[ai][bj][m][1]; } asm volatile("" ::: "memory"); }
    }
};
struct EpiSwiglu {
    static constexpr bool PERM = true, AFTER_DRAIN = false;
    bf16_t* A;
    __device__ __forceinline__ void operator()(const f32x4 (&acc)[2][2][4][2], const Unit& u, int wr, int wc, int fr, int fq) const {
        const int row0 = u.pm * BM + wr * 64 + fr; const int q0 = wc * 32 + 8 * fq;
#pragma unroll
        for (int ai = 0; ai < 2; ++ai)
#pragma unroll
            for (int m = 0; m < 4; ++m) { const int row = row0 + ai * HALF + m * 16;
                f32x4 g0 = acc[ai][0][m][0], g1 = acc[ai][0][m][1]; asm volatile("" : "+v"(g0), "+v"(g1));
                store16(A + (size_t)row * 2816 + u.pn * 128 + q0, silu4(g0) * acc[ai][1][m][0], silu4(g1) * acc[ai][1][m][1]); asm volatile("" ::: "memory"); }
    }
};
template <class Epi, class Sched, bool ALIGN_EPI = false, bool SP2 = false>
__device__ __forceinline__ void gemm_phase(PG8_LAS unsigned char* lds, const Gemm g, const Sched& S, const Epi& E) {
    int tid_ = threadIdx.x; asm volatile("" : "+v"(tid_));
    const int tid = tid_, wid = __builtin_amdgcn_readfirstlane(tid >> 6), lane = tid & 63, wr = wid >> 2, wc = wid & 3, fr = lane & 15, fq = lane >> 4;
    const int K = g.K, nt = K / BK;
    unsigned voffA[2], voffB[2];
#pragma unroll
    for (int i = 0; i < 2; ++i) { int R, C; stage_rc(tid * 16 + i * 8192, R, C); const int Rb = Epi::PERM ? ((R & ~31) + perm32(R & 31)) : R;
        voffA[i] = (unsigned)(R * K + C) * 2u; voffB[i] = (unsigned)(Rb * K + C) * 2u; }
    const size_t kstep = (size_t)(BK * 2);
    const size_t hstep = (size_t)HALF * K * 2;
    const size_t tstep = 2 * hstep;
    const unsigned ldsw = (unsigned)wid * 1024u;
    const int aoff = lds_byte(wr * 64 + fr, fq * 8), boff = lds_byte(wc * 32 + fr, fq * 8);
#define PG8_SA(b, h) (((b) * 2 + (h)) * HTB)
#define PG8_SB(b, h) ((4 + (b) * 2 + (h)) * HTB)
#define PG8_STAGE(bufoff, gbase, voff) do { _Pragma("unroll") for (int _i = 0; _i < 2; ++_i) \
        __builtin_amdgcn_global_load_lds((const unsigned*)((const char*)(gbase) + (voff)[_i]), (PG8_LAS unsigned*)(lds + (bufoff) + ldsw + _i * 8192), 16, 0, 0); } while (0)
#define PG8_LDA(dst, b, h) do { _Pragma("unroll") for (int m = 0; m < 4; ++m) _Pragma("unroll") for (int k = 0; k < 2; ++k) dst[m][k] = *(const PG8_LAS bf16x8*)(lds + PG8_SA(b, h) + aoff + m * 2048 + k * 1024); } while (0)
#define PG8_LDB(dst, b, h) do { _Pragma("unroll") for (int n = 0; n < 2; ++n) _Pragma("unroll") for (int k = 0; k < 2; ++k) dst[n][k] = *(const PG8_LAS bf16x8*)(lds + PG8_SB(b, h) + boff + n * 2048 + k * 1024); } while (0)
#define PG8_MMA(ai, bj, At, Bt) do { __builtin_amdgcn_s_setprio(1); _Pragma("unroll") for (int m = 0; m < 4; ++m) _Pragma("unroll") for (int n = 0; n < 2; ++n) _Pragma("unroll") for (int k = 0; k < 2; ++k) \
        acc[ai][bj][m][n] = __builtin_amdgcn_mfma_f32_16x16x32_bf16(Bt[n][k], At[m][k], acc[ai][bj][m][n], 0, 0, 0); __builtin_amdgcn_s_setprio(0); } while (0)
#define PG8_WAIT_V(n) asm volatile("s_waitcnt vmcnt(" #n ")" ::: "memory")
#define PG8_WAIT_L(n) asm volatile("s_waitcnt lgkmcnt(" #n ")" ::: "memory")
#define PG8_BAR __builtin_amdgcn_s_barrier()
#define PG8_SCHED __builtin_amdgcn_sched_barrier(0)
    Unit cur, nxt; int ui = 0;
    if (!S.next(0, cur)) return;
    f32x4 acc[2][2][4][2];
#pragma unroll
    for (int a = 0; a < 2; ++a)
#pragma unroll
        for (int b = 0; b < 2; ++b)
#pragma unroll
            for (int m = 0; m < 4; ++m)
#pragma unroll
                for (int n = 0; n < 2; ++n) acc[a][b][m][n] = (f32x4){0.f, 0.f, 0.f, 0.f};
    bf16x8 At[4][2], B0[2][2], B1[2][2];
    const char* cA = (const char*)g.A + (size_t)cur.pm * tstep; const char* cB = (const char*)g.Bt + (size_t)cur.pn * tstep;
    S.a_ready(cur);
    if constexpr (SP2) {
        PG8_STAGE(PG8_SB(0, 0), cB, voffB); PG8_STAGE(PG8_SB(0, 1), cB + hstep, voffB); PG8_STAGE(PG8_SA(0, 0), cA, voffA); PG8_STAGE(PG8_SA(0, 1), cA + hstep, voffA);
        if (wr == 1) PG8_BAR;
        PG8_WAIT_V(2); PG8_BAR;
        PG8_STAGE(PG8_SB(1, 0), cB + kstep, voffB); PG8_STAGE(PG8_SA(1, 0), cA + kstep, voffA); PG8_STAGE(PG8_SB(1, 1), cB + hstep + kstep, voffB);
        PG8_WAIT_V(6); PG8_BAR;
    } else {
        PG8_STAGE(PG8_SB(0, 0), cB, voffB); PG8_STAGE(PG8_SA(0, 0), cA, voffA); PG8_STAGE(PG8_SB(0, 1), cB + hstep, voffB); PG8_STAGE(PG8_SA(0, 1), cA + hstep, voffA);
        if (wr == 1) PG8_BAR;
        PG8_WAIT_V(4); PG8_BAR;
        PG8_STAGE(PG8_SB(1, 0), cB + kstep, voffB); PG8_STAGE(PG8_SA(1, 0), cA + kstep, voffA); PG8_STAGE(PG8_SB(1, 1), cB + hstep + kstep, voffB);
        PG8_WAIT_V(6); PG8_BAR;
    }
    for (;;) {
        const bool has_next = S.next(ui + 1, nxt);
        const char* nA = has_next ? (const char*)g.A + (size_t)nxt.pm * tstep : cA; const char* nB = has_next ? (const char*)g.Bt + (size_t)nxt.pn * tstep : cB;
        for (int t = 0; t < nt; t += 2) {
            const bool last = (t == nt - 2);
            const char* a1 = cA + (size_t)(t + 1) * kstep;
            const char* a2 = last ? nA : cA + (size_t)(t + 2) * kstep; const char* b2 = last ? nB : cB + (size_t)(t + 2) * kstep;
            const char* a3 = a2 + kstep; const char* b3 = b2 + kstep;
            if (last && has_next) S.a_ready(nxt);
            if constexpr (SP2) {
            PG8_LDB(B0, 0, 0); PG8_LDB(B1, 0, 1); PG8_SCHED; PG8_LDA(At, 0, 0); PG8_STAGE(PG8_SA(1, 1), a1 + hstep, voffA);
            PG8_WAIT_V(8); PG8_WAIT_L(0); PG8_BAR; PG8_MMA(0, 0, At, B0); PG8_MMA(0, 1, At, B1); PG8_BAR; PG8_SCHED;
            PG8_LDA(At, 0, 1); PG8_STAGE(PG8_SB(0, 0), b2, voffB); PG8_STAGE(PG8_SB(0, 1), b2 + hstep, voffB); PG8_STAGE(PG8_SA(0, 0), a2, voffA);
            PG8_WAIT_V(8); PG8_WAIT_L(0); PG8_BAR; PG8_MMA(1, 0, At, B0); PG8_MMA(1, 1, At, B1); PG8_BAR; PG8_SCHED;
            PG8_LDB(B0, 1, 0); PG8_LDB(B1, 1, 1); PG8_SCHED; PG8_LDA(At, 1, 0); PG8_STAGE(PG8_SA(0, 1), a2 + hstep, voffA);
            PG8_WAIT_V(8); PG8_WAIT_L(0); PG8_BAR; PG8_MMA(0, 0, At, B0); PG8_MMA(0, 1, At, B1); PG8_BAR; PG8_SCHED;
            PG8_LDA(At, 1, 1); PG8_STAGE(PG8_SB(1, 0), b3, voffB); PG8_STAGE(PG8_SB(1, 1), b3 + hstep, voffB); PG8_STAGE(PG8_SA(1, 0), a3, voffA);
            PG8_WAIT_V(8); PG8_WAIT_L(0); PG8_BAR; PG8_MMA(1, 0, At, B0); PG8_MMA(1, 1, At, B1); PG8_BAR; PG8_SCHED;
            } else {
            PG8_LDB(B0, 0, 0); PG8_SCHED; PG8_LDA(At, 0, 0); PG8_STAGE(PG8_SA(1, 1), a1 + hstep, voffA);
            PG8_WAIT_L(8); PG8_BAR; PG8_WAIT_L(0); PG8_MMA(0, 0, At, B0); PG8_BAR; PG8_SCHED;
            PG8_LDB(B1, 0, 1); PG8_STAGE(PG8_SB(0, 0), b2, voffB);
            PG8_BAR; PG8_WAIT_L(0); PG8_MMA(0, 1, At, B1); PG8_BAR;
            PG8_LDA(At, 0, 1); PG8_STAGE(PG8_SA(0, 0), a2, voffA);
            PG8_BAR; PG8_WAIT_L(0); PG8_MMA(1, 0, At, B0); PG8_BAR; PG8_SCHED;
            PG8_STAGE(PG8_SB(0, 1), b2 + hstep, voffB);
            PG8_WAIT_V(6); PG8_BAR; PG8_MMA(1, 1, At, B1); PG8_BAR;
            PG8_LDB(B0, 1, 0); PG8_SCHED; PG8_LDA(At, 1, 0); PG8_STAGE(PG8_SA(0, 1), a2 + hstep, voffA);
            PG8_WAIT_L(8); PG8_BAR; PG8_WAIT_L(0); PG8_MMA(0, 0, At, B0); PG8_BAR; PG8_SCHED;
            PG8_LDB(B1, 1, 1); PG8_STAGE(PG8_SB(1, 0), b3, voffB);
            PG8_BAR; PG8_WAIT_L(0); PG8_MMA(0, 1, At, B1); PG8_BAR;
            PG8_LDA(At, 1, 1); PG8_STAGE(PG8_SA(1, 0), a3, voffA);
            PG8_BAR; PG8_WAIT_L(0); PG8_MMA(1, 0, At, B0); PG8_BAR; PG8_SCHED;
            PG8_STAGE(PG8_SB(1, 1), b3 + hstep, voffB);
            PG8_WAIT_V(6); PG8_BAR; PG8_MMA(1, 1, At, B1); PG8_BAR;
            }
        }
        if constexpr (ALIGN_EPI) { if (wr == 0) PG8_BAR; }
        if constexpr (!Epi::AFTER_DRAIN) { E(acc, cur, wr, wc, fr, fq); S.done(cur); }
        if (!has_next) break;
#pragma unroll
        for (int a = 0; a < 2; ++a)
#pragma unroll
            for (int b = 0; b < 2; ++b)
#pragma unroll
                for (int m = 0; m < 4; ++m)
#pragma unroll
                    for (int n = 0; n < 2; ++n) acc[a][b][m][n] = (f32x4){0.f, 0.f, 0.f, 0.f};
        cur = nxt; cA = nA; cB = nB; ++ui;
        if constexpr (ALIGN_EPI) { if (wr == 1) PG8_BAR; }
    }
    PG8_WAIT_V(0);
    if constexpr (!ALIGN_EPI) { if (wr == 0) PG8_BAR; }
    PG8_BAR;
    if constexpr (Epi::AFTER_DRAIN) { E.fused(acc, cur, wr, wc, fr, fq, lds, wid, lane); S.done(cur); }
#undef PG8_SA
#undef PG8_SB
#undef PG8_STAGE
#undef PG8_LDA
#undef PG8_LDB
#undef PG8_MMA
#undef PG8_WAIT_V
#undef PG8_WAIT_L
#undef PG8_BAR
#undef PG8_SCHED
}
}
#define LAS __attribute__((address_space(3)))
using pg8::bf16_t; using pg8::bf16x8; using pg8::f32x4; using pg8::u32x4; using pg8::cvt_pk_bf16;
typedef short s16x4 __attribute__((ext_vector_type(4)));
typedef unsigned u32x2 __attribute__((ext_vector_type(2)));
constexpr int SEQ = 2048, DM = 1024, NTOK = 65536, DEPTH = 4, HWID = pg8::HWID, FFH = 2816, NSEQ = 32;
constexpr float LOG2E = 1.4426950408889634f;
constexpr float ALPHA = 1.681792830507429f;
constexpr float LN_EPS = 1e-5f;
constexpr size_t MiB = (size_t)1 << 20;
constexpr size_t WS_CTL = 0, WS_TABR = 1 * MiB, WS_TABD = 2 * MiB, WS_WIN = 4 * MiB, WS_WA = 76 * MiB, WS_WB = 84 * MiB, WS_WC = 88 * MiB, WS_WO = 92 * MiB,
                 WS_WFI = 100 * MiB, WS_WFO = 144 * MiB, WS_ACT = 168 * MiB;
constexpr int LDS_BYTES = 147456, QSLOT_OFF = 143360;

struct Params { const float* in[20]; float* out; unsigned char* ws; int G; int pad; };

#define MFMA16(a, b, c) __builtin_amdgcn_mfma_f32_16x16x32_bf16((a), (b), (c), 0, 0, 0)
__device__ __forceinline__ s16x4 tr_read(LAS unsigned char* p) { return __builtin_bit_cast(s16x4, __builtin_amdgcn_ds_read_tr16_b64_v4i16((LAS s16x4*)p)); }
__device__ __forceinline__ bf16x8 cat8(s16x4 lo, s16x4 hi) { return __builtin_shufflevector(lo, hi, 0, 1, 2, 3, 4, 5, 6, 7); }
__device__ __forceinline__ bf16x8 pack8(const f32x4 a, const f32x4 b) { u32x4 w; w.x = cvt_pk_bf16(a[0], a[1]); w.y = cvt_pk_bf16(a[2], a[3]); w.z = cvt_pk_bf16(b[0], b[1]); w.w = cvt_pk_bf16(b[2], b[3]); return __builtin_bit_cast(bf16x8, w); }
__device__ __forceinline__ float ex2(float x) { return __builtin_amdgcn_exp2f(x); }
__device__ __forceinline__ float wave_sum(float v) {
#pragma unroll
    for (int o = 1; o < 64; o <<= 1) v += __shfl_xor(v, o);
    return v;
}
__device__ __forceinline__ unsigned f2bf(float f) { unsigned u = __float_as_uint(f); return (u + 0x7fffu + ((u >> 16) & 1u)) >> 16; }
__device__ __forceinline__ unsigned pk2(float lo, float hi) { return f2bf(lo) | (f2bf(hi) << 16); }

__device__ __forceinline__ int map_in(int n0) { const int t = n0 >> 8, p = n0 & 255;
    if (t < 4) return 256 * t + ((p & 127) >> 6) * 128 + (p >> 7) * 64 + (p & 63);
    if (t >= 18 && t < 22) return 256 * t + ((p & 127) >> 5) * 64 + (p >> 7) * 32 + (p & 31);
    return n0; }
__device__ __forceinline__ int map_ffn(int n0) { const int t = n0 >> 8, p = n0 & 255; return p < 128 ? 128 * t + p : FFH + 128 * t + (p - 128); }

__device__ __forceinline__ void transpose_item(const float* W, int K, int N, bf16_t* WT, LAS float* scr, int kb, int n0, int nsrc, int lane) {
    const int k0 = 64 * kb;
#pragma unroll 8
    for (int i = 0; i < 32; ++i) { const int kk = 2 * i + (lane >> 5); scr[kk * 33 + (lane & 31)] = W[(size_t)(k0 + kk) * N + nsrc + (lane & 31)]; }
    asm volatile("s_waitcnt lgkmcnt(0)" ::: "memory");
    const int c = lane & 7;
#pragma unroll
    for (int j = 0; j < 4; ++j) { const int n = (lane >> 3) + 8 * j; const LAS float* s = scr + (8 * c) * 33 + n;
        u32x4 o; o.x = pk2(s[0 * 33], s[1 * 33]); o.y = pk2(s[2 * 33], s[3 * 33]); o.z = pk2(s[4 * 33], s[5 * 33]); o.w = pk2(s[6 * 33], s[7 * 33]);
        *(u32x4*)(WT + (size_t)(n0 + n) * K + k0 + 8 * c) = o; }
    asm volatile("s_waitcnt lgkmcnt(0)" ::: "memory");
}

template <bool DA>
__device__ __forceinline__ void attn_unit(LAS unsigned char* lds, const bf16_t* H, int bl, int chunk, int quad, bf16_t* Oout,
                                          const float* biasL, float lam, float oscale, const float* normg) {
    int tid_ = threadIdx.x; asm volatile("" : "+v"(tid_));
    const int tid = tid_, wid = __builtin_amdgcn_readfirstlane(tid >> 6), lane = tid & 63, fr = lane & 15, g = lane >> 4;
    const int hq = wid >> 1, qh = wid & 1;
    constexpr int QCOL = DA ? 4608 : 3072, KCOL = DA ? 5120 : 3584, VCOL = DA ? 5632 : 4096;
    constexpr int RS = 528;
    constexpr int NVB = DA ? 8 : 4;
    LAS unsigned char* Kimg = lds; LAS unsigned char* Vimg = lds + 64 * RS;
    LAS float* biasLds = (LAS float*)(lds + 2 * 64 * RS);
    const size_t rowbase = (size_t)bl * SEQ;
    const int t0 = chunk * 64;
    const int tile_lo = DA ? 0 : (chunk > 8 ? chunk - 8 : 0), tile_hi = chunk;
    __syncthreads();
    bf16x8 qf[2][2];
#pragma unroll
    for (int qb = 0; qb < 2; ++qb)
#pragma unroll
        for (int s = 0; s < 2; ++s) qf[qb][s] = *(const bf16x8*)(H + (rowbase + t0 + qh * 32 + qb * 16 + fr) * HWID + QCOL + quad * 256 + hq * 64 + s * 32 + g * 8);
    if (!DA) { for (int i = tid; i < 4 * 513; i += 512) { const int hh = i / 513, r = i - hh * 513; biasLds[hh * 516 + r] = biasL[(quad * 4 + hh) * 513 + r] * LOG2E; } }
    f32x4 oacc[NVB][2];
#pragma unroll
    for (int vb = 0; vb < NVB; ++vb) { oacc[vb][0] = (f32x4){0.f, 0.f, 0.f, 0.f}; oacc[vb][1] = (f32x4){0.f, 0.f, 0.f, 0.f}; }
    float mrun[2] = {-1e30f, -1e30f}, lrun[2] = {0.f, 0.f};
    u32x4 pk[4], pv[4];
    const int prow = tid >> 5, pc = tid & 31;
    {   const bf16_t* src = H + (rowbase + tile_lo * 64 + prow) * HWID + quad * 256 + pc * 8;
#pragma unroll
        for (int k = 0; k < 4; ++k) { pk[k] = *(const u32x4*)(src + (size_t)k * 16 * HWID + KCOL); pv[k] = *(const u32x4*)(src + (size_t)k * 16 * HWID + VCOL); } }
    const int vcol0 = DA ? (hq >> 1) * 128 : hq * 64;
    for (int tile = tile_lo; tile <= tile_hi; ++tile) {
        __syncthreads();
#pragma unroll
        for (int k = 0; k < 4; ++k) { *(LAS u32x4*)(Kimg + (prow + 16 * k) * RS + pc * 16) = pk[k]; *(LAS u32x4*)(Vimg + (prow + 16 * k) * RS + pc * 16) = pv[k]; }
        __syncthreads();
        if (tile < tile_hi) { const bf16_t* src = H + (rowbase + (tile + 1) * 64 + prow) * HWID + quad * 256 + pc * 8;
#pragma unroll
            for (int k = 0; k < 4; ++k) { pk[k] = *(const u32x4*)(src + (size_t)k * 16 * HWID + KCOL); pv[k] = *(const u32x4*)(src + (size_t)k * 16 * HWID + VCOL); } }
        f32x4 sacc[4][2];
#pragma unroll
        for (int kb = 0; kb < 4; ++kb) { sacc[kb][0] = (f32x4){0.f, 0.f, 0.f, 0.f}; sacc[kb][1] = (f32x4){0.f, 0.f, 0.f, 0.f};
#pragma unroll
            for (int s = 0; s < 2; ++s) { const bf16x8 kf = *(const LAS bf16x8*)(Kimg + (kb * 16 + fr) * RS + (hq * 64 + s * 32 + g * 8) * 2);
                sacc[kb][0] = MFMA16(kf, qf[0][s], sacc[kb][0]); sacc[kb][1] = MFMA16(kf, qf[1][s], sacc[kb][1]); } }
        if (!DA) {
#pragma unroll
            for (int kb = 0; kb < 4; ++kb)
#pragma unroll
                for (int qb = 0; qb < 2; ++qb)
#pragma unroll
                    for (int i = 0; i < 4; ++i) { const int key = tile * 64 + kb * 16 + 4 * g + i, q = t0 + qh * 32 + qb * 16 + fr; int rel = q - key; rel = rel < -256 ? -256 : (rel > 256 ? 256 : rel);
                        sacc[kb][qb][i] += biasLds[hq * 516 + rel + 256]; }
        }
        bf16x8 pf[2][2];
#pragma unroll
        for (int qb = 0; qb < 2; ++qb) {
            float mx = -1e30f;
#pragma unroll
            for (int kb = 0; kb < 4; ++kb)
#pragma unroll
                for (int i = 0; i < 4; ++i) mx = fmaxf(mx, sacc[kb][qb][i]);
            mx = fmaxf(mx, __shfl_xor(mx, 16)); mx = fmaxf(mx, __shfl_xor(mx, 32));
            const float mnew = fmaxf(mrun[qb], mx), alpha = ex2(mrun[qb] - mnew); mrun[qb] = mnew;
            float rs = 0.f;
#pragma unroll
            for (int kb = 0; kb < 4; ++kb)
#pragma unroll
                for (int i = 0; i < 4; ++i) { const float p = ex2(sacc[kb][qb][i] - mnew); sacc[kb][qb][i] = p; rs += p; }
            rs += __shfl_xor(rs, 16); rs += __shfl_xor(rs, 32);
            lrun[qb] = lrun[qb] * alpha + rs;
#pragma unroll
            for (int vb = 0; vb < NVB; ++vb) oacc[vb][qb] = oacc[vb][qb] * alpha;
            pf[qb][0] = pack8(sacc[0][qb], sacc[1][qb]); pf[qb][1] = pack8(sacc[2][qb], sacc[3][qb]);
        }
#pragma unroll
        for (int vb = 0; vb < NVB; ++vb)
#pragma unroll
            for (int s2 = 0; s2 < 2; ++s2) {
                const s16x4 lo = tr_read(Vimg + (32 * s2 + 4 * g + (fr >> 2)) * RS + (vcol0 + 16 * vb + 4 * (fr & 3)) * 2);
                const s16x4 hi = tr_read(Vimg + (32 * s2 + 16 + 4 * g + (fr >> 2)) * RS + (vcol0 + 16 * vb + 4 * (fr & 3)) * 2);
                const bf16x8 vf = cat8(lo, hi);
                oacc[vb][0] = MFMA16(vf, pf[0][s2], oacc[vb][0]); oacc[vb][1] = MFMA16(vf, pf[1][s2], oacc[vb][1]); }
    }
    const float inv0 = 1.0f / lrun[0], inv1 = 1.0f / lrun[1];
    if (!DA) {
#pragma unroll
        for (int qb = 0; qb < 2; ++qb) { const float inv = qb ? inv1 : inv0; bf16_t* dst = Oout + (rowbase + t0 + qh * 32 + qb * 16 + fr) * 512 + (quad * 4 + hq) * 64 + 4 * g;
#pragma unroll
            for (int vb = 0; vb < NVB; ++vb) { const f32x4 o = oacc[vb][qb] * inv; u32x2 w; w.x = cvt_pk_bf16(o[0], o[1]); w.y = cvt_pk_bf16(o[2], o[3]); *(u32x2*)(dst + 16 * vb) = w; } }
    } else {
        __syncthreads();
        LAS float* ex = (LAS float*)lds + ((hq >> 1) * 2 + qh) * 4096 + lane;
        if (hq & 1) {
#pragma unroll
            for (int vb = 0; vb < NVB; ++vb)
#pragma unroll
                for (int qb = 0; qb < 2; ++qb)
#pragma unroll
                    for (int i = 0; i < 4; ++i) ex[((vb * 2 + qb) * 4 + i) * 64] = oacc[vb][qb][i] * (qb ? inv1 : inv0);
        }
        __syncthreads();
        if (!(hq & 1)) {
#pragma unroll
            for (int qb = 0; qb < 2; ++qb) { const float inv = qb ? inv1 : inv0; float ss = 0.f;
#pragma unroll
                for (int vb = 0; vb < NVB; ++vb)
#pragma unroll
                    for (int i = 0; i < 4; ++i) { const float o = oacc[vb][qb][i] * inv - lam * ex[((vb * 2 + qb) * 4 + i) * 64]; oacc[vb][qb][i] = o; ss += o * o; }
                ss += __shfl_xor(ss, 16); ss += __shfl_xor(ss, 32);
                const float r = oscale / sqrtf(ss * (1.0f / 128.0f) + LN_EPS);
                bf16_t* dst = Oout + (rowbase + t0 + qh * 32 + qb * 16 + fr) * 512 + (quad * 2 + (hq >> 1)) * 128 + 4 * g;
#pragma unroll
                for (int vb = 0; vb < NVB; ++vb) { const f32x4 ng = *(const f32x4*)(normg + 16 * vb + 4 * g); const f32x4 o = oacc[vb][qb] * ng * r;
                    u32x2 w; w.x = cvt_pk_bf16(o[0], o[1]); w.y = cvt_pk_bf16(o[2], o[3]); *(u32x2*)(dst + 16 * vb) = w; } }
        }
    }
}

__device__ __forceinline__ void ret_unit(LAS unsigned char* lds, const bf16_t* H, int bl, int h, bf16_t* OA, const float* normg) {
    int tid_ = threadIdx.x; asm volatile("" : "+v"(tid_));
    const int tid = tid_, wid = __builtin_amdgcn_readfirstlane(tid >> 6), lane = tid & 63, fr = lane & 15, g = lane >> 4;
    constexpr int QS = 272, VS = 528, PS = 144;
    LAS unsigned char* Qimg = lds; LAS unsigned char* Kimg = lds + 64 * QS; LAS unsigned char* K2img = lds + 2 * 64 * QS; LAS unsigned char* Vimg = lds + 3 * 64 * QS;
    LAS unsigned char* Pimg = Vimg + 64 * VS; LAS float* part = (LAS float*)(Pimg + 64 * PS);
    const float lg2 = log2f(1.0f - ex2(-5.0f - (float)h));
    const float cd = ex2(lg2 * 64.0f);
    const size_t rowbase = (size_t)bl * SEQ;
    f32x4 st[8][2];
#pragma unroll
    for (int db = 0; db < 8; ++db) { st[db][0] = (f32x4){0.f, 0.f, 0.f, 0.f}; st[db][1] = (f32x4){0.f, 0.f, 0.f, 0.f}; }
    const int qrow = tid >> 4, qc = tid & 15;
    const int vrow = tid >> 5, vc = tid & 31;
    const int rb1 = wid >> 1, ch1 = wid & 1;
    for (int c = 0; c < 32; ++c) {
        __syncthreads();
        {   const bf16_t* src = H + (rowbase + c * 64) * HWID;
#pragma unroll
            for (int k = 0; k < 2; ++k) { const int r = qrow + 32 * k; const u32x4 q = *(const u32x4*)(src + (size_t)r * HWID + h * 128 + qc * 8); const u32x4 kk = *(const u32x4*)(src + (size_t)r * HWID + 512 + h * 128 + qc * 8);
                *(LAS u32x4*)(Qimg + r * QS + qc * 16) = q; *(LAS u32x4*)(Kimg + r * QS + qc * 16) = kk;
                f32x4 a, b; pg8::unpack8(kk, a, b); const float kd = ex2(lg2 * (float)(63 - r)); *(LAS bf16x8*)(K2img + r * QS + qc * 16) = pack8(a * kd, b * kd); }
#pragma unroll
            for (int k = 0; k < 4; ++k) { const int r = vrow + 16 * k; *(LAS u32x4*)(Vimg + r * VS + vc * 16) = *(const u32x4*)(src + (size_t)r * HWID + 1024 + h * 256 + vc * 8); } }
        __syncthreads();
        {   f32x4 pa[2] = {(f32x4){0.f, 0.f, 0.f, 0.f}, (f32x4){0.f, 0.f, 0.f, 0.f}};
#pragma unroll
            for (int s = 0; s < 4; ++s) { const bf16x8 qa = *(const LAS bf16x8*)(Qimg + (16 * rb1 + fr) * QS + (32 * s + 8 * g) * 2);
#pragma unroll
                for (int cb = 0; cb < 2; ++cb) { const bf16x8 kbf = *(const LAS bf16x8*)(Kimg + (32 * ch1 + 16 * cb + fr) * QS + (32 * s + 8 * g) * 2); pa[cb] = MFMA16(qa, kbf, pa[cb]); } }
#pragma unroll
            for (int cb = 0; cb < 2; ++cb)
#pragma unroll
                for (int i = 0; i < 4; ++i) { const int n = 16 * rb1 + 4 * g + i, m = 32 * ch1 + 16 * cb + fr; const int d = n > m ? n - m : m - n;
                    *(LAS unsigned short*)(Pimg + n * PS + m * 2) = (unsigned short)f2bf(pa[cb][i] * ex2(lg2 * (float)d)); } }
        __syncthreads();
        bf16x8 vfr[2][2];
#pragma unroll
        for (int cb = 0; cb < 2; ++cb)
#pragma unroll
            for (int s2 = 0; s2 < 2; ++s2) { const s16x4 lo = tr_read(Vimg + (32 * s2 + 8 * g + (fr >> 2)) * VS + (32 * wid + 16 * cb + 4 * (fr & 3)) * 2);
                const s16x4 hi = tr_read(Vimg + (32 * s2 + 8 * g + 4 + (fr >> 2)) * VS + (32 * wid + 16 * cb + 4 * (fr & 3)) * 2); vfr[cb][s2] = cat8(lo, hi); }
        f32x4 oa[4][2];
#pragma unroll
        for (int rb = 0; rb < 4; ++rb) { oa[rb][0] = (f32x4){0.f, 0.f, 0.f, 0.f}; oa[rb][1] = (f32x4){0.f, 0.f, 0.f, 0.f}; }
#pragma unroll
        for (int s = 0; s < 4; ++s) { const bf16x8 sb0 = pack8(st[2 * s][0], st[2 * s + 1][0]), sb1 = pack8(st[2 * s][1], st[2 * s + 1][1]);
#pragma unroll
            for (int rb = 0; rb < 4; ++rb) { const s16x4 lo = *(const LAS s16x4*)(Qimg + (16 * rb + fr) * QS + (32 * s + 4 * g) * 2), hi = *(const LAS s16x4*)(Qimg + (16 * rb + fr) * QS + (32 * s + 16 + 4 * g) * 2);
                const bf16x8 qa = cat8(lo, hi); oa[rb][0] = MFMA16(qa, sb0, oa[rb][0]); oa[rb][1] = MFMA16(qa, sb1, oa[rb][1]); } }
#pragma unroll
        for (int rb = 0; rb < 4; ++rb)
#pragma unroll
            for (int i = 0; i < 4; ++i) { const float qd = ex2(lg2 * (float)(16 * rb + 4 * g + i + 1)); oa[rb][0][i] *= qd; oa[rb][1][i] *= qd; }
#pragma unroll
        for (int rb = 0; rb < 4; ++rb)
#pragma unroll
            for (int s2 = 0; s2 < 2; ++s2) { const bf16x8 pa = *(const LAS bf16x8*)(Pimg + (16 * rb + fr) * PS + (32 * s2 + 8 * g) * 2);
                oa[rb][0] = MFMA16(pa, vfr[0][s2], oa[rb][0]); oa[rb][1] = MFMA16(pa, vfr[1][s2], oa[rb][1]); }
#pragma unroll
        for (int db = 0; db < 8; ++db) { st[db][0] = st[db][0] * cd; st[db][1] = st[db][1] * cd;
#pragma unroll
            for (int s2 = 0; s2 < 2; ++s2) { const s16x4 lo = tr_read(K2img + (32 * s2 + 8 * g + (fr >> 2)) * QS + (16 * db + 4 * (fr & 3)) * 2);
                const s16x4 hi = tr_read(K2img + (32 * s2 + 8 * g + 4 + (fr >> 2)) * QS + (16 * db + 4 * (fr & 3)) * 2); const bf16x8 ka = cat8(lo, hi);
                st[db][0] = MFMA16(ka, vfr[0][s2], st[db][0]); st[db][1] = MFMA16(ka, vfr[1][s2], st[db][1]); } }
#pragma unroll
        for (int rb = 0; rb < 4; ++rb)
#pragma unroll
            for (int i = 0; i < 4; ++i) { float ss = oa[rb][0][i] * oa[rb][0][i] + oa[rb][1][i] * oa[rb][1][i];
                ss += __shfl_xor(ss, 1); ss += __shfl_xor(ss, 2); ss += __shfl_xor(ss, 4); ss += __shfl_xor(ss, 8);
                if (fr == 0) part[wid * 64 + 16 * rb + 4 * g + i] = ss; }
        __syncthreads();
#pragma unroll
        for (int rb = 0; rb < 4; ++rb)
#pragma unroll
            for (int i = 0; i < 4; ++i) { const int n = 16 * rb + 4 * g + i; float tot = 0.f;
#pragma unroll
                for (int w = 0; w < 8; ++w) tot += part[w * 64 + n];
                const float r = 1.0f / sqrtf(tot * (1.0f / 256.0f) + LN_EPS);
                const size_t row = rowbase + c * 64 + n;
#pragma unroll
                for (int cb = 0; cb < 2; ++cb) { const int e = 32 * wid + 16 * cb + fr; const float gt = __uint_as_float((unsigned)H[row * HWID + 2048 + h * 256 + e] << 16);
                    OA[row * 1024 + h * 256 + e] = (bf16_t)f2bf(oa[rb][cb][i] * r * normg[e] * gt); } }
    }
}

__global__ void __launch_bounds__(512, 2) fwd_kernel(Params P) {
    extern __shared__ __attribute__((aligned(16))) unsigned char lds_raw[];
    LAS unsigned char* lds = (LAS unsigned char*)lds_raw;
    cg::grid_group grid = cg::this_grid();
    const int tid = threadIdx.x, lane = tid & 63, wave = __builtin_amdgcn_readfirstlane(tid >> 6);
    const int NB = gridDim.x, bid = blockIdx.x;
    const int gw = bid * 8 + wave, NGW = NB * 8;
    unsigned char* ws = P.ws;
    const int G = P.G, Mg = G * SEQ, ngrp = NSEQ / G;
    float* tabR = (float*)(ws + WS_TABR); float* tabD = (float*)(ws + WS_TABD);
    bf16_t* WinT = (bf16_t*)(ws + WS_WIN); bf16_t* WaT = (bf16_t*)(ws + WS_WA); bf16_t* WbT = (bf16_t*)(ws + WS_WB); bf16_t* WcT = (bf16_t*)(ws + WS_WC);
    bf16_t* WoT = (bf16_t*)(ws + WS_WO); bf16_t* WfiT = (bf16_t*)(ws + WS_WFI); bf16_t* WfoT = (bf16_t*)(ws + WS_WFO);
    bf16_t* XB = (bf16_t*)(ws + WS_ACT); bf16_t* Hb = XB + (size_t)Mg * 1024; bf16_t* OA = Hb + (size_t)Mg * HWID; bf16_t* OB = OA + (size_t)Mg * 1024; bf16_t* OC = OB + (size_t)Mg * 512;
    bf16_t* ACT = Hb;
    unsigned* qcnt = (unsigned*)(ws + WS_CTL);

    {
        LAS float* scr = (LAS float*)(lds + wave * 16384);
        constexpr int I_IN = 16 * 288, I_A = 16 * 32, I_B = 8 * 32, I_C = 8 * 32, I_O = 16 * 32, I_FI = 16 * 176, I_FO = 44 * 32;
        constexpr int I_L = I_IN + I_A + I_B + I_C + I_O + I_FI + I_FO;
        for (int it = gw; it < DEPTH * I_L; it += NGW) {
            const int l = it / I_L; int r = it - l * I_L;
            if (r < I_IN) { const int kb = r / 288, n0 = 32 * (r % 288); transpose_item(P.in[1] + (size_t)l * 1024 * HWID, 1024, HWID, WinT + (size_t)l * HWID * 1024, scr, kb, n0, map_in(n0), lane); continue; } r -= I_IN;
            if (r < I_A) { const int kb = r / 32, n0 = 32 * (r % 32); transpose_item(P.in[9] + (size_t)l * 1024 * 1024, 1024, 1024, WaT + (size_t)l * 1024 * 1024, scr, kb, n0, n0, lane); continue; } r -= I_A;
            if (r < I_B) { const int kb = r / 32, n0 = 32 * (r % 32); transpose_item(P.in[10] + (size_t)l * 512 * 1024, 512, 1024, WbT + (size_t)l * 1024 * 512, scr, kb, n0, n0, lane); continue; } r -= I_B;
            if (r < I_C) { const int kb = r / 32, n0 = 32 * (r % 32); transpose_item(P.in[11] + (size_t)l * 512 * 1024, 512, 1024, WcT + (size_t)l * 1024 * 512, scr, kb, n0, n0, lane); continue; } r -= I_C;
            if (r < I_O) { const int kb = r / 32, n0 = 32 * (r % 32); transpose_item(P.in[13] + (size_t)l * 1024 * 1024, 1024, 1024, WoT + (size_t)l * 1024 * 1024, scr, kb, n0, n0, lane); continue; } r -= I_O;
            if (r < I_FI) { const int kb = r / 176, n0 = 32 * (r % 176); transpose_item(P.in[16] + (size_t)l * 1024 * 2 * FFH, 1024, 2 * FFH, WfiT + (size_t)l * 2 * FFH * 1024, scr, kb, n0, map_ffn(n0), lane); continue; } r -= I_FI;
            { const int kb = r / 32, n0 = 32 * (r % 32); transpose_item(P.in[17] + (size_t)l * FFH * 1024, FFH, 1024, WfoT + (size_t)l * 1024 * FFH, scr, kb, n0, n0, lane); }
        }
        for (int i = bid * 512 + tid; i < SEQ * 96; i += NB * 512) {
            int pos, j; float invf; float* cdst; float* sdst;
            if (i < SEQ * 64) { pos = i >> 6; j = i & 63; invf = powf(10000.0f, -(float)(2 * j) / 128.0f); cdst = tabR + i; sdst = tabR + SEQ * 64 + i; }
            else { const int i2 = i - SEQ * 64; pos = i2 >> 5; j = i2 & 31; invf = powf(10000.0f, -(float)(2 * j) / 64.0f); cdst = tabD + i2; sdst = tabD + SEQ * 32 + i2; }
            const float ang = (float)pos * invf;
            const double rev = (double)ang * 0.15915494309189535; const float fr_ = (float)(rev - floor(rev));
            *cdst = __builtin_amdgcn_cosf(fr_); *sdst = __builtin_amdgcn_sinf(fr_);
        }
    }
    grid.sync();

    for (int grp = 0; grp < ngrp; ++grp) {
        const size_t goff = (size_t)grp * Mg * 1024;
        float* X = P.out + goff;
        {   const f32x4* src = (const f32x4*)(P.in[0] + goff); u32x2* dst = (u32x2*)XB; int t_ = tid; asm volatile("" : "+v"(t_));
            for (size_t i = (size_t)bid * 512 + t_; i < (size_t)Mg * 256; i += (size_t)NB * 512) { const f32x4 v = src[i]; u32x2 w; w.x = cvt_pk_bf16(v[0], v[1]); w.y = cvt_pk_bf16(v[2], v[3]); dst[i] = w; } }
        grid.sync();
        for (int l = 0; l < DEPTH; ++l) {
            for (int half = 0; half < 2; ++half) {
                if (half == 0) {
                    {   pg8::Gemm gm{XB, WinT + (size_t)l * HWID * 1024, Mg, HWID, 1024}; pg8::StaticOrder S; S.init(Mg, HWID, NB, bid);
                        pg8::EpiIn E{Hb, P.in[12] + l * 3072, tabR, tabD};

#ifndef NO_G1
pg8::gemm_phase<pg8::EpiIn, pg8::StaticOrder, true, true>(lds, gm, S, E);
#endif
 }
                    grid.sync();
                    {   const float lambda_init = 0.8f - 0.6f * expf(-0.3f * (float)l);
                        float d1 = 0.f, d2 = 0.f;
                        for (int i = 0; i < 64; ++i) { d1 += P.in[4][l * 64 + i] * P.in[5][l * 64 + i]; d2 += P.in[6][l * 64 + i] * P.in[7][l * 64 + i]; }
                        const float lam = expf(d1) - expf(d2) + lambda_init;
                        const int NR = G * 4, NDA = G * 64, NU = NR + 2 * NDA;
                        volatile LAS int* qslot = (volatile LAS int*)(lds + QSLOT_OFF);
                        for (;;) {
                            __syncthreads();
                            if (tid == 0) *qslot = (int)atomicAdd(qcnt + grp * DEPTH + l, 1u);
                            __syncthreads();
                            const int u = *qslot;
                            if (u >= NU) break;
                            if (u < NR) {
#ifndef NO_RET
 ret_unit(lds, Hb, u >> 2, u & 3, OA, P.in[2] + l * 256);
#endif
 }
                            else if (u < NR + NDA) { const int v = u - NR; const int chunk = 31 - v / (2 * G), rem = v % (2 * G);
#ifndef NO_DA
 attn_unit<true>(lds, Hb, rem >> 1, chunk, rem & 1, OC, nullptr, lam, 1.0f - lambda_init, P.in[8] + l * 128);
#endif
 }
                            else { const int v = u - NR - NDA; const int chunk = 31 - v / (2 * G), rem = v % (2 * G);
#ifndef NO_CA
 attn_unit<false>(lds, Hb, rem >> 1, chunk, rem & 1, OB, P.in[3] + l * 8 * 513, 0.f, 1.f, nullptr);
#endif
 }
                        }
                    }
                    grid.sync();
                    for (int br = 0; br < 3; ++br) {
                        const bf16_t* A = br == 0 ? OA : (br == 1 ? OB : OC); const int K = br == 0 ? 1024 : 512;
                        const bf16_t* Bt = br == 0 ? WaT + (size_t)l * 1024 * 1024 : (br == 1 ? WbT + (size_t)l * 1024 * 512 : WcT + (size_t)l * 1024 * 512);
                        pg8::Gemm gm{A, Bt, Mg, 1024, K}; pg8::StaticOrder S; S.init(Mg, 1024, NB, bid);
                        pg8::EpiBranch E{XB, Hb, br, br == 0};

#ifndef NO_G3
pg8::gemm_phase<pg8::EpiBranch, pg8::StaticOrder, true, true>(lds, gm, S, E);
#endif

                    }
                    grid.sync();
                } else {
                    {   pg8::Gemm gm{XB, WfiT + (size_t)l * 2 * FFH * 1024, Mg, 2 * FFH, 1024}; pg8::StaticOrder S; S.init(Mg, 2 * FFH, NB, bid);
                        pg8::EpiSwiglu E{ACT};

#ifndef NO_G5
pg8::gemm_phase<pg8::EpiSwiglu, pg8::StaticOrder, true, true>(lds, gm, S, E);
#endif
 }
                    grid.sync();
                }
                {   const bf16_t* A = half == 0 ? XB : ACT; const int K = half == 0 ? 1024 : FFH;
                    const bf16_t* Bt = half == 0 ? WoT + (size_t)l * 1024 * 1024 : WfoT + (size_t)l * 1024 * FFH;
                    const float* resid = (half == 0 && l == 0) ? P.in[0] + goff : X;
                    pg8::Gemm gm{A, Bt, Mg, 1024, K}; pg8::StaticOrder S; S.init(Mg, 1024, NB, bid);
                    pg8::EpiResid E{resid, X, ALPHA};

#ifndef NO_G4
pg8::gemm_phase<pg8::EpiResid, pg8::StaticOrder, true, true>(lds, gm, S, E);
#endif
 }
                grid.sync();
                {   const float* gam = (half == 0 ? P.in[14] : P.in[18]) + l * 1024; const float* bet = (half == 0 ? P.in[15] : P.in[19]) + l * 1024;
                    f32x4 gv[4], bv[4]; int lane_ = lane; asm volatile("" : "+v"(lane_));
#define lane lane_
#pragma unroll
                    for (int j = 0; j < 4; ++j) { gv[j] = *((const f32x4*)gam + lane + 64 * j); bv[j] = *((const f32x4*)bet + lane + 64 * j); }
                    for (int m = gw; m < Mg; m += NGW) {
                        f32x4* xr = (f32x4*)(X + (size_t)m * 1024) + lane; f32x4 v[4]; float s = 0.f;
#pragma unroll
                        for (int j = 0; j < 4; ++j) { v[j] = xr[64 * j]; s += (v[j][0] + v[j][1]) + (v[j][2] + v[j][3]); }
                        const float mean = wave_sum(s) * (1.0f / 1024.0f); float s2 = 0.f;
#pragma unroll
                        for (int j = 0; j < 4; ++j) { v[j] = v[j] - mean; s2 += (v[j][0] * v[j][0] + v[j][1] * v[j][1]) + (v[j][2] * v[j][2] + v[j][3] * v[j][3]); }
                        const float rstd = 1.0f / sqrtf(wave_sum(s2) * (1.0f / 1024.0f) + LN_EPS);
                        u32x2* o8 = (u32x2*)(XB + (size_t)m * 1024) + lane;
#pragma unroll
                        for (int j = 0; j < 4; ++j) { const f32x4 y = v[j] * rstd * gv[j] + bv[j]; xr[64 * j] = y; u32x2 w; w.x = cvt_pk_bf16(y[0], y[1]); w.y = cvt_pk_bf16(y[2], y[3]); o8[64 * j] = w; }
                    }
#undef lane
                }
                grid.sync();
            }
        }
    }
}

extern "C" void kernel_launch(void* const* d_in, const int* in_sizes, int n_in, void* d_out, int out_size, void* d_ws, size_t ws_size, hipStream_t stream) {
    static int grid_blocks = 0;
    if (grid_blocks == 0) {
        int dev = 0, cus = 0, per_cu = 0;
        hipGetDevice(&dev); hipDeviceGetAttribute(&cus, hipDeviceAttributeMultiprocessorCount, dev);
        hipFuncSetAttribute((const void*)fwd_kernel, hipFuncAttributeMaxDynamicSharedMemorySize, LDS_BYTES);
        hipOccupancyMaxActiveBlocksPerMultiprocessor(&per_cu, (const void*)fwd_kernel, 512, LDS_BYTES);
        if (per_cu < 1) per_cu = 1;
        grid_blocks = cus;
        (void)hipGetLastError();
    }
    int G = 16;
    while (G > 1 && WS_ACT + (size_t)G * SEQ * 24576 > ws_size) G >>= 1;
    hipMemsetAsync(d_ws, 0, 4096, stream);
    Params p{};
    for (int i = 0; i < 20; ++i) p.in[i] = (const float*)d_in[i];
    p.out = (float*)d_out; p.ws = (unsigned char*)d_ws; p.G = G; p.pad = 0;
    void* args[] = {&p};
    hipError_t e = hipLaunchCooperativeKernel((const void*)fwd_kernel, dim3(grid_blocks), dim3(512), args, LDS_BYTES, stream);
    if (e != hipSuccess) fprintf(stderr, "cooperative launch failed: %s (grid %d)\n", hipGetErrorString(e), grid_blocks);
}
```

```cpp
#include <hip/hip_runtime.h>
#include <hip/hip_cooperative_groups.h>
#include <cstdio>
#include <cstdint>
#include <cmath>
namespace cg = cooperative_groups;
namespace pg8 {
#define PG8_LAS __attribute__((address_space(3)))
typedef unsigned short bf16_t;
typedef short bf16x8 __attribute__((ext_vector_type(8)));
typedef float f32x4 __attribute__((ext_vector_type(4)));
typedef unsigned u32x4 __attribute__((ext_vector_type(4)));
constexpr int BM = 256, BK = 64, HALF = 128, HTB = HALF * BK * 2  , STAGE_BYTES = 8 * HTB, NXCD = 8, WGM = 8;

__host__ __device__ __forceinline__ int lds_byte(int r, int c) { const int st = (r >> 4) * 2 + (c >> 5), rr = r & 15, cc = c & 31, ob = rr * 64 + cc * 2; return st * 1024 + (ob ^ (((ob >> 9) & 1) << 5)); }
__host__ __device__ __forceinline__ void stage_rc(int b, int& R, int& C) { const int st = b / 1024, sb = b % 1024, swz = sb ^ (((sb >> 9) & 1) << 5); R = (st >> 1) * 16 + swz / 64; C = (st & 1) * 32 + (swz % 64) / 2; }
__host__ __device__ __forceinline__ int perm32(int rho) { const int n = rho >> 4, i = rho & 15; return 8 * (i >> 2) + 4 * n + (i & 3); }

struct Unit { int pm, pn; };
struct Gemm { const bf16_t* A; const bf16_t* Bt; int M, N, K; };

struct StaticOrder {
    int nM, nN, nwg, G, c;
    __host__ __device__ void init(int M, int N, int G_, int c_) { nM = M / BM; nN = N / BM; nwg = nM * nN; G = G_; c = c_; }
    __host__ __device__ bool next(int i, Unit& u) const {
        const long L = (long)i * G + c; if (L >= nwg) return false;
        int wgid = (int)L; { const int q = nwg / NXCD, r = nwg % NXCD, xcd = wgid % NXCD, off = wgid / NXCD; wgid = (xcd < r ? xcd * (q + 1) : r * (q + 1) + (xcd - r) * q) + off; }
        const int nig = WGM * nN, gid = wgid / nig, fm = gid * WGM, gsz = (nM - fm) < WGM ? (nM - fm) : WGM;
        u.pm = fm + ((wgid % nig) % gsz); u.pn = (wgid % nig) / gsz; return true;
    }
    __device__ __forceinline__ void a_ready(const Unit&) const {}
    __device__ __forceinline__ void done(const Unit&) const {}
};

__device__ __forceinline__ unsigned cvt_pk_bf16(float lo, float hi) { unsigned r; asm volatile("v_cvt_pk_bf16_f32 %0, %1, %2" : "=v"(r) : "v"(lo), "v"(hi)); return r; }
__device__ __forceinline__ void store16(bf16_t* dst, const f32x4 a, const f32x4 b) {
    u32x4 w; w.x = cvt_pk_bf16(a[0], a[1]); w.y = cvt_pk_bf16(a[2], a[3]); w.z = cvt_pk_bf16(b[0], b[1]); w.w = cvt_pk_bf16(b[2], b[3]); *(u32x4*)dst = w;
}
__device__ __forceinline__ float fast_sigmoid(float x) { return __builtin_amdgcn_rcpf(1.0f + __builtin_amdgcn_exp2f(-1.4426950408889634f * x)); }
__device__ __forceinline__ f32x4 silu4(f32x4 v) { f32x4 r; r[0] = v[0] * fast_sigmoid(v[0]); r[1] = v[1] * fast_sigmoid(v[1]); r[2] = v[2] * fast_sigmoid(v[2]); r[3] = v[3] * fast_sigmoid(v[3]); return r; }
__device__ __forceinline__ f32x4 sigm4(f32x4 v) { f32x4 r; r[0] = fast_sigmoid(v[0]); r[1] = fast_sigmoid(v[1]); r[2] = fast_sigmoid(v[2]); r[3] = fast_sigmoid(v[3]); return r; }
__device__ __forceinline__ void unpack8(const u32x4 w, f32x4& a, f32x4& b) {
    a[0] = __uint_as_float(w.x << 16); a[1] = __uint_as_float(w.x & 0xffff0000u); a[2] = __uint_as_float(w.y << 16); a[3] = __uint_as_float(w.y & 0xffff0000u);
    b[0] = __uint_as_float(w.z << 16); b[1] = __uint_as_float(w.z & 0xffff0000u); b[2] = __uint_as_float(w.w << 16); b[3] = __uint_as_float(w.w & 0xffff0000u);
}
constexpr int HWID = 9216;
constexpr float C2F = 0.125f * 1.4426950408889634f;

struct EpiIn {
    static constexpr bool PERM = true, AFTER_DRAIN = false;
    bf16_t* H; const float* bmerge; const float* tabR; const float* tabD;
    __device__ __forceinline__ void operator()(const f32x4 (&acc)[2][2][4][2], const Unit& u, int wr, int wc, int fr, int fq) const {
        const int pn = u.pn; const int row0 = u.pm * BM + wr * 64 + fr; const int q0 = wc * 32 + 8 * fq;
        if (pn < 4) {
            const float sc = pn >= 2 ? 0.08838834764831845f : 1.0f; const int head = q0 >> 6, i0 = q0 & 63;
#pragma unroll
            for (int ai = 0; ai < 2; ++ai)
#pragma unroll
                for (int m = 0; m < 4; ++m) { const int row = row0 + ai * HALF + m * 16; const int pos = row & 2047;
                    const float* cp = tabR + pos * 64 + i0; const float* sp = cp + 2048 * 64;
                    const f32x4 c0 = *(const f32x4*)cp, c1 = *(const f32x4*)(cp + 4), s0 = *(const f32x4*)sp, s1 = *(const f32x4*)(sp + 4);
                    const f32x4 x1a = acc[ai][0][m][0], x1b = acc[ai][0][m][1], x2a = acc[ai][1][m][0], x2b = acc[ai][1][m][1];
                    bf16_t* dst = H + (size_t)row * HWID + pn * 256 + head * 128 + i0;
                    store16(dst, (x1a * c0 - x2a * s0) * sc, (x1b * c1 - x2b * s1) * sc);
                    store16(dst + 64, (x2a * c0 + x1a * s0) * sc, (x2b * c1 + x1b * s1) * sc); asm volatile("" ::: "memory"); }
        } else if (pn >= 18 && pn < 22) {
            const float sc = pn < 20 ? C2F : 1.0f; const int head = q0 >> 5, i0 = q0 & 31;
#pragma unroll
            for (int ai = 0; ai < 2; ++ai)
#pragma unroll
                for (int m = 0; m < 4; ++m) { const int row = row0 + ai * HALF + m * 16; const int pos = row & 2047;
                    const float* cp = tabD + pos * 32 + i0; const float* sp = cp + 2048 * 32;
                    const f32x4 c0 = *(const f32x4*)cp, c1 = *(const f32x4*)(cp + 4), s0 = *(const f32x4*)sp, s1 = *(const f32x4*)(sp + 4);
                    const f32x4 x1a = acc[ai][0][m][0], x1b = acc[ai][0][m][1], x2a = acc[ai][1][m][0], x2b = acc[ai][1][m][1];
                    bf16_t* dst = H + (size_t)row * HWID + pn * 256 + head * 64 + i0;
                    store16(dst, (x1a * c0 - x2a * s0) * sc, (x1b * c1 - x2b * s1) * sc);
                    store16(dst + 32, (x2a * c0 + x1a * s0) * sc, (x2b * c1 + x1b * s1) * sc); asm volatile("" ::: "memory"); }
        } else {
            const int mode = (pn >= 24) ? 2 : ((pn >= 8 && pn < 12) ? 1 : 0); const float sc = (pn == 12 || pn == 13) ? C2F : 1.0f;
#pragma unroll
            for (int bj = 0; bj < 2; ++bj) { const int c = pn * 256 + bj * HALF + q0;
                f32x4 b0 = (f32x4){0.f, 0.f, 0.f, 0.f}, b1 = b0;
                if (mode == 2) { b0 = *(const f32x4*)(bmerge + (c - 6144)); b1 = *(const f32x4*)(bmerge + (c - 6144) + 4); }
#pragma unroll
                for (int ai = 0; ai < 2; ++ai)
#pragma unroll
                    for (int m = 0; m < 4; ++m) { const int row = row0 + ai * HALF + m * 16;
                        f32x4 v0 = acc[ai][bj][m][0], v1 = acc[ai][bj][m][1]; asm volatile("" : "+v"(v0), "+v"(v1));
                        if (mode == 2) { v0 = sigm4(v0 + b0); v1 = sigm4(v1 + b1); } else if (mode == 1) { v0 = silu4(v0); v1 = silu4(v1); } else { v0 = v0 * sc; v1 = v1 * sc; }
                        store16(H + (size_t)row * HWID + c, v0, v1); asm volatile("" ::: "memory"); } }
        }
    }
};
struct EpiBranch {
    static constexpr bool PERM = true, AFTER_DRAIN = false;
    bf16_t* Mg; const bf16_t* H; int gsel; int first;
    __device__ __forceinline__ void operator()(const f32x4 (&acc)[2][2][4][2], const Unit& u, int wr, int wc, int fr, int fq) const {
        const int row0 = u.pm * BM + wr * 64 + fr; const int q0 = wc * 32 + 8 * fq;
#pragma unroll
        for (int ai = 0; ai < 2; ++ai)
#pragma unroll
            for (int m = 0; m < 4; ++m) { const int row = row0 + ai * HALF + m * 16;
#pragma unroll
                for (int bj = 0; bj < 2; ++bj) { const int c = u.pn * 256 + bj * HALF + q0;
                    f32x4 g0, g1; unpack8(*(const u32x4*)(H + (size_t)row * HWID + 6144 + gsel * 1024 + c), g0, g1);
                    f32x4 v0 = g0 * acc[ai][bj][m][0], v1 = g1 * acc[ai][bj][m][1];
                    bf16_t* dst = Mg + (size_t)row * 1024 + c;
                    if (!first) { f32x4 o0, o1; unpack8(*(const u32x4*)dst, o0, o1); v0 = v0 + o0; v1 = v1 + o1; }
                    store16(dst, v0, v1); } asm volatile("" ::: "memory"); }
    }
};
struct EpiResid {
    static constexpr bool PERM = true, AFTER_DRAIN = false;
    const float* resid; float* Y; float alpha;
    __device__ __forceinline__ void operator()(const f32x4 (&acc)[2][2][4][2], const Unit& u, int wr, int wc, int fr, int fq) const {
        const int row0 = u.pm * BM + wr * 64 + fr; const int q0 = wc * 32 + 8 * fq;
#pragma unroll
        for (int ai = 0; ai < 2; ++ai)
#pragma unroll
            for (int m = 0; m < 4; ++m) { const int row = row0 + ai * HALF + m * 16;
#pragma unroll
                for (int bj = 0; bj < 2; ++bj) { const size_t p = (size_t)row * 1024 + u.pn * 256 + bj * HALF + q0;
                    const f32x4 r0 = *(const f32x4*)(resid + p), r1 = *(const f32x4*)(resid + p + 4);
                    *(f32x4*)(Y + p) = r0 * alpha + acc[ai][bj][m][0]; *(f32x4*)(Y + p + 4) = r1 * alpha + acc[ai][bj][m][1]; } asm volatile("" ::: "memory"); }
    }
};
struct EpiSwiglu {
    static constexpr bool PERM = true, AFTER_DRAIN = false;
    bf16_t* A;
    __device__ __forceinline__ void operator()(const f32x4 (&acc)[2][2][4][2], const Unit& u, int wr, int wc, int fr, int fq) const {
        const int row0 = u.pm * BM + wr * 64 + fr; const int q0 = wc * 32 + 8 * fq;
#pragma unroll
        for (int ai = 0; ai < 2; ++ai)
#pragma unroll
            for (int m = 0; m < 4; ++m) { const int row = row0 + ai * HALF + m * 16;
                f32x4 g0 = acc[ai][0][m][0], g1 = acc[ai][0][m][1]; asm volatile("" : "+v"(g0), "+v"(g1));
                store16(A + (size_t)row * 2816 + u.pn * 128 + q0, silu4(g0) * acc[ai][1][m][0], silu4(g1) * acc[ai][1][m][1]); asm volatile("" ::: "memory"); }
    }
};
template <class Epi, class Sched, bool ALIGN_EPI = false, bool SP2 = false>
__device__ __forceinline__ void gemm_phase(PG8_LAS unsigned char* lds, const Gemm g, const Sched& S, const Epi& E) {
    int tid_ = threadIdx.x; asm volatile("" : "+v"(tid_));
    const int tid = tid_, wid = __builtin_amdgcn_readfirstlane(tid >> 6), lane = tid & 63, wr = wid >> 2, wc = wid & 3, fr = lane & 15, fq = lane >> 4;
    const int K = g.K, nt = K / BK;
    unsigned voffA[2], voffB[2];
#pragma unroll
    for (int i = 0; i < 2; ++i) { int R, C; stage_rc(tid * 16 + i * 8192, R, C); const int Rb = Epi::PERM ? ((R & ~31) + perm32(R & 31)) : R;
        voffA[i] = (unsigned)(R * K + C) * 2u; voffB[i] = (unsigned)(Rb * K + C) * 2u; }
    const size_t kstep = (size_t)(BK * 2);
    const size_t hstep = (size_t)HALF * K * 2;
    const size_t tstep = 2 * hstep;
    const unsigned ldsw = (unsigned)wid * 1024u;
    const int aoff = lds_byte(wr * 64 + fr, fq * 8), boff = lds_byte(wc * 32 + fr, fq * 8);
#define PG8_SA(b, h) (((b) * 2 + (h)) * HTB)
#define PG8_SB(b, h) ((4 + (b) * 2 + (h)) * HTB)
#define PG8_STAGE(bufoff, gbase, voff) do { _Pragma("unroll") for (int _i = 0; _i < 2; ++_i) \
        __builtin_amdgcn_global_load_lds((const unsigned*)((const char*)(gbase) + (voff)[_i]), (PG8_LAS unsigned*)(lds + (bufoff) + ldsw + _i * 8192), 16, 0, 0); } while (0)
#define PG8_LDA(dst, b, h) do { _Pragma("unroll") for (int m = 0; m < 4; ++m) _Pragma("unroll") for (int k = 0; k < 2; ++k) dst[m][k] = *(const PG8_LAS bf16x8*)(lds + PG8_SA(b, h) + aoff + m * 2048 + k * 1024); } while (0)
#define PG8_LDB(dst, b, h) do { _Pragma("unroll") for (int n = 0; n < 2; ++n) _Pragma("unroll") for (int k = 0; k < 2; ++k) dst[n][k] = *(const PG8_LAS bf16x8*)(lds + PG8_SB(b, h) + boff + n * 2048 + k * 1024); } while (0)
#define PG8_MMA(ai, bj, At, Bt) do { __builtin_amdgcn_s_setprio(1); _Pragma("unroll") for (int m = 0; m < 4; ++m) _Pragma("unroll") for (int n = 0; n < 2; ++n) _Pragma("unroll") for (int k = 0; k < 2; ++k) \
        acc[ai][bj][m][n] = __builtin_amdgcn_mfma_f32_16x16x32_bf16(Bt[n][k], At[m][k], acc[ai][bj][m][n], 0, 0, 0); __builtin_amdgcn_s_setprio(0); } while (0)
#define PG8_WAIT_V(n) asm volatile("s_waitcnt vmcnt(" #n ")" ::: "memory")
#define PG8_WAIT_L(n) asm volatile("s_waitcnt lgkmcnt(" #n ")" ::: "memory")
#define PG8_BAR __builtin_amdgcn_s_barrier()
#define PG8_SCHED __builtin_amdgcn_sched_barrier(0)
    Unit cur, nxt; int ui = 0;
    if (!S.next(0, cur)) return;
    f32x4 acc[2][2][4][2];
#pragma unroll
    for (int a = 0; a < 2; ++a)
#pragma unroll
        for (int b = 0; b < 2; ++b)
#pragma unroll
            for (int m = 0; m < 4; ++m)
#pragma unroll
                for (int n = 0; n < 2; ++n) acc[a][b][m][n] = (f32x4){0.f, 0.f, 0.f, 0.f};
    bf16x8 At[4][2], B0[2][2], B1[2][2];
    const char* cA = (const char*)g.A + (size_t)cur.pm * tstep; const char* cB = (const char*)g.Bt + (size_t)cur.pn * tstep;
    S.a_ready(cur);
    if constexpr (SP2) {
        PG8_STAGE(PG8_SB(0, 0), cB, voffB); PG8_STAGE(PG8_SB(0, 1), cB + hstep, voffB); PG8_STAGE(PG8_SA(0, 0), cA, voffA); PG8_STAGE(PG8_SA(0, 1), cA + hstep, voffA);
        if (wr == 1) PG8_BAR;
        PG8_WAIT_V(2); PG8_BAR;
        PG8_STAGE(PG8_SB(1, 0), cB + kstep, voffB); PG8_STAGE(PG8_SA(1, 0), cA + kstep, voffA); PG8_STAGE(PG8_SB(1, 1), cB + hstep + kstep, voffB);
        PG8_WAIT_V(6); PG8_BAR;
    } else {
        PG8_STAGE(PG8_SB(0, 0), cB, voffB); PG8_STAGE(PG8_SA(0, 0), cA, voffA); PG8_STAGE(PG8_SB(0, 1), cB + hstep, voffB); PG8_STAGE(PG8_SA(0, 1), cA + hstep, voffA);
        if (wr == 1) PG8_BAR;
        PG8_WAIT_V(4); PG8_BAR;
        PG8_STAGE(PG8_SB(1, 0), cB + kstep, voffB); PG8_STAGE(PG8_SA(1, 0), cA + kstep, voffA); PG8_STAGE(PG8_SB(1, 1), cB + hstep + kstep, voffB);
        PG8_WAIT_V(6); PG8_BAR;
    }
    for (;;) {
        const bool has_next = S.next(ui + 1, nxt);
        const char* nA = has_next ? (const char*)g.A + (size_t)nxt.pm * tstep : cA; const char* nB = has_next ? (const char*)g.Bt + (size_t)nxt.pn * tstep : cB;
        for (int t = 0; t < nt; t += 2) {
            const bool last = (t == nt - 2);
            const char* a1 = cA + (size_t)(t + 1) * kstep;
            const char* a2 = last ? nA : cA + (size_t)(t + 2) * kstep; const char* b2 = last ? nB : cB + (size_t)(t + 2) * kstep;
            const char* a3 = a2 + kstep; const char* b3 = b2 + kstep;
            if (last && has_next) S.a_ready(nxt);
            if constexpr (SP2) {
            PG8_LDB(B0, 0, 0); PG8_LDB(B1, 0, 1); PG8_SCHED; PG8_LDA(At, 0, 0); PG8_STAGE(PG8_SA(1, 1), a1 + hstep, voffA);
            PG8_WAIT_V(8); PG8_WAIT_L(0); PG8_BAR; PG8_MMA(0, 0, At, B0); PG8_MMA(0, 1, At, B1); PG8_BAR; PG8_SCHED;
            PG8_LDA(At, 0, 1); PG8_STAGE(PG8_SB(0, 0), b2, voffB); PG8_STAGE(PG8_SB(0, 1), b2 + hstep, voffB); PG8_STAGE(PG8_SA(0, 0), a2, voffA);
            PG8_WAIT_V(8); PG8_WAIT_L(0); PG8_BAR; PG8_MMA(1, 0, At, B0); PG8_MMA(1, 1, At, B1); PG8_BAR; PG8_SCHED;
            PG8_LDB(B0, 1, 0); PG8_LDB(B1, 1, 1); PG8_SCHED; PG8_LDA(At, 1, 0); PG8_STAGE(PG8_SA(0, 1), a2 + hstep, voffA);
            PG8_WAIT_V(8); PG8_WAIT_L(0); PG8_BAR; PG8_MMA(0, 0, At, B0); PG8_MMA(0, 1, At, B1); PG8_BAR; PG8_SCHED;
            PG8_LDA(At, 1, 1); PG8_STAGE(PG8_SB(1, 0), b3, voffB); PG8_STAGE(PG8_SB(1, 1), b3 + hstep, voffB); PG8_STAGE(PG8_SA(1, 0), a3, voffA);
            PG8_WAIT_V(8); PG8_WAIT_L(0); PG8_BAR; PG8_MMA(1, 0, At, B0); PG8_MMA(1, 1, At, B1); PG8_BAR; PG8_SCHED;
            } else {
            PG8_LDB(B0, 0, 0); PG8_SCHED; PG8_LDA(At, 0, 0); PG8_STAGE(PG8_SA(1, 1), a1 + hstep, voffA);
            PG8_WAIT_L(8); PG8_BAR; PG8_WAIT_L(0); PG8_MMA(0, 0, At, B0); PG8_BAR; PG8_SCHED;
            PG8_LDB(B1, 0, 1); PG8_STAGE(PG8_SB(0, 0), b2, voffB);
            PG8_BAR; PG8_WAIT_L(0); PG8_MMA(0, 1, At, B1); PG8_BAR;
            PG8_LDA(At, 0, 1); PG8_STAGE(PG8_SA(0, 0), a2, voffA);
            PG8_BAR; PG8_WAIT_L(0); PG8_MMA(1, 0, At, B0); PG8_BAR; PG8_SCHED;
            PG8_STAGE(PG8_SB(0, 1), b2 + hstep, voffB);
            PG8_WAIT_V(6); PG8_BAR; PG8_MMA(1, 1, At, B1); PG8_BAR;
            PG8_LDB(B0, 1, 0); PG8_SCHED; PG8_LDA(At, 1, 0); PG8_STAGE(PG8_SA(0, 1), a2 + hstep, voffA);
            PG8_WAIT_L(8); PG8_BAR; PG8_WAIT_L(0); PG8_MMA(0, 0, At, B0); PG8_BAR; PG8_SCHED;
            PG8_LDB(B1, 1, 1); PG8_STAGE(PG8_SB(1, 0), b3, voffB);
            PG8_BAR; PG8_WAIT_L(0); PG8_MMA(0, 1, At, B1); PG8_BAR;
            PG8_LDA(At, 1, 1); PG8_STAGE(PG8_SA(1, 0), a3, voffA);
            PG8_BAR; PG8_WAIT_L(0); PG8_MMA(1, 0, At, B0); PG8_BAR; PG8_SCHED;
            PG8_STAGE(PG8_SB(1, 1), b3 + hstep, voffB);
            PG8_WAIT_V(6); PG8_BAR; PG8_MMA(1, 1, At, B1); PG8_BAR;
            }
        }
        if constexpr (ALIGN_EPI) { if (wr == 0) PG8_BAR; }
        if constexpr (!Epi::AFTER_DRAIN) { E(acc, cur, wr, wc, fr, fq); S.done(cur); }
        if (!has_next) break;
#pragma unroll
        for (int a = 0; a < 2; ++a)
#pragma unroll
            for (int b = 0; b < 2; ++b)
#pragma unroll
                for (int m = 0; m < 4; ++m)
#pragma unroll
                    for (int n = 0; n < 2; ++n) acc[a][b][m][n] = (f32x4){0.f, 0.f, 0.f, 0.f};
        cur = nxt; cA = nA; cB = nB; ++ui;
        if constexpr (ALIGN_EPI) { if (wr == 1) PG8_BAR; }
    }
    PG8_WAIT_V(0);
    if constexpr (!ALIGN_EPI) { if (wr == 0) PG8_BAR; }
    PG8_BAR;
    if constexpr (Epi::AFTER_DRAIN) { E.fused(acc, cur, wr, wc, fr, fq, lds, wid, lane); S.done(cur); }
#undef PG8_SA
#undef PG8_SB
#undef PG8_STAGE
#undef PG8_LDA
#undef PG8_LDB
#undef PG8_MMA
#undef PG8_WAIT_V
#undef PG8_WAIT_L
#undef PG8_BAR
#undef PG8_SCHED
}
}
#define LAS __attribute__((address_space(3)))
using pg8::bf16_t; using pg8::bf16x8; using pg8::f32x4; using pg8::u32x4; using pg8::cvt_pk_bf16;
typedef short s16x4 __attribute__((ext_vector_type(4)));
typedef unsigned u32x2 __attribute__((ext_vector_type(2)));
constexpr int SEQ = 2048, DM = 1024, NTOK = 65536, DEPTH = 4, HWID = pg8::HWID, FFH = 2816, NSEQ = 32;
constexpr float LOG2E = 1.4426950408889634f;
constexpr float ALPHA = 1.681792830507429f;
constexpr float LN_EPS = 1e-5f;
constexpr size_t MiB = (size_t)1 << 20;
constexpr size_t WS_CTL = 0, WS_TABR = 1 * MiB, WS_TABD = 2 * MiB, WS_WIN = 4 * MiB, WS_WA = 76 * MiB, WS_WB = 84 * MiB, WS_WC = 88 * MiB, WS_WO = 92 * MiB,
                 WS_WFI = 100 * MiB, WS_WFO = 144 * MiB, WS_ACT = 168 * MiB;
constexpr int LDS_BYTES = 147456, QSLOT_OFF = 143360;

struct Params { const float* in[20]; float* out; unsigned char* ws; int G; int pad; };

#define MFMA16(a, b, c) __builtin_amdgcn_mfma_f32_16x16x32_bf16((a), (b), (c), 0, 0, 0)
__device__ __forceinline__ s16x4 tr_read(LAS unsigned char* p) { return __builtin_bit_cast(s16x4, __builtin_amdgcn_ds_read_tr16_b64_v4i16((LAS s16x4*)p)); }
__device__ __forceinline__ bf16x8 cat8(s16x4 lo, s16x4 hi) { return __builtin_shufflevector(lo, hi, 0, 1, 2, 3, 4, 5, 6, 7); }
__device__ __forceinline__ bf16x8 pack8(const f32x4 a, const f32x4 b) { u32x4 w; w.x = cvt_pk_bf16(a[0], a[1]); w.y = cvt_pk_bf16(a[2], a[3]); w.z = cvt_pk_bf16(b[0], b[1]); w.w = cvt_pk_bf16(b[2], b[3]); return __builtin_bit_cast(bf16x8, w); }
__device__ __forceinline__ float ex2(float x) { return __builtin_amdgcn_exp2f(x); }
__device__ __forceinline__ float wave_sum(float v) {
#pragma unroll
    for (int o = 1; o < 64; o <<= 1) v += __shfl_xor(v, o);
    return v;
}
__device__ __forceinline__ unsigned f2bf(float f) { unsigned u = __float_as_uint(f); return (u + 0x7fffu + ((u >> 16) & 1u)) >> 16; }
__device__ __forceinline__ unsigned pk2(float lo, float hi) { return f2bf(lo) | (f2bf(hi) << 16); }

__device__ __forceinline__ int map_in(int n0) { const int t = n0 >> 8, p = n0 & 255;
    if (t < 4) return 256 * t + ((p & 127) >> 6) * 128 + (p >> 7) * 64 + (p & 63);
    if (t >= 18 && t < 22) return 256 * t + ((p & 127) >> 5) * 64 + (p >> 7) * 32 + (p & 31);
    return n0; }
__device__ __forceinline__ int map_ffn(int n0) { const int t = n0 >> 8, p = n0 & 255; return p < 128 ? 128 * t + p : FFH + 128 * t + (p - 128); }

__device__ __forceinline__ void transpose_item(const float* W, int K, int N, bf16_t* WT, LAS float* scr, int kb, int n0, int nsrc, int lane) {
    const int k0 = 64 * kb;
#pragma unroll 8
    for (int i = 0; i < 32; ++i) { const int kk = 2 * i + (lane >> 5); scr[kk * 33 + (lane & 31)] = W[(size_t)(k0 + kk) * N + nsrc + (lane & 31)]; }
    asm volatile("s_waitcnt lgkmcnt(0)" ::: "memory");
    const int c = lane & 7;
#pragma unroll
    for (int j = 0; j < 4; ++j) { const int n = (lane >> 3) + 8 * j; const LAS float* s = scr + (8 * c) * 33 + n;
        u32x4 o; o.x = pk2(s[0 * 33], s[1 * 33]); o.y = pk2(s[2 * 33], s[3 * 33]); o.z = pk2(s[4 * 33], s[5 * 33]); o.w = pk2(s[6 * 33], s[7 * 33]);
        *(u32x4*)(WT + (size_t)(n0 + n) * K + k0 + 8 * c) = o; }
    asm volatile("s_waitcnt lgkmcnt(0)" ::: "memory");
}

template <bool DA>
__device__ __forceinline__ void attn_unit(LAS unsigned char* lds, const bf16_t* __restrict__ H, int bl, int chunk, int quad, bf16_t* __restrict__ Oout,
                                          const float* __restrict__ biasL, float lam, float oscale, const float* __restrict__ normg) {
    int tid_ = threadIdx.x; asm volatile("" : "+v"(tid_));
    const int tid = tid_, wid = __builtin_amdgcn_readfirstlane(tid >> 6), lane = tid & 63, fr = lane & 15, g = lane >> 4;
    const int hq = wid >> 1, qh = wid & 1;
    constexpr int QCOL = DA ? 4608 : 3072, KCOL = DA ? 5120 : 3584, VCOL = DA ? 5632 : 4096;
    constexpr int RS = 528;
    constexpr int NVB = DA ? 8 : 4;
    LAS unsigned char* Kimg = lds; LAS unsigned char* Vimg = lds + 64 * RS;
    LAS float* biasLds = (LAS float*)(lds + 2 * 64 * RS);
    const size_t rowbase = (size_t)bl * SEQ;
    const int t0 = chunk * 64;
    const int tile_lo = DA ? 0 : (chunk > 8 ? chunk - 8 : 0), tile_hi = chunk;
    __syncthreads();
    bf16x8 qf[2][2];
#pragma unroll
    for (int qb = 0; qb < 2; ++qb)
#pragma unroll
        for (int s = 0; s < 2; ++s) qf[qb][s] = *(const bf16x8*)(H + (rowbase + t0 + qh * 32 + qb * 16 + fr) * HWID + QCOL + quad * 256 + hq * 64 + s * 32 + g * 8);
    if (!DA) { for (int i = tid; i < 4 * 513; i += 512) { const int hh = i / 513, r = i - hh * 513; biasLds[hh * 516 + r] = biasL[(quad * 4 + hh) * 513 + r] * LOG2E; } }
    f32x4 oacc[NVB][2];
#pragma unroll
    for (int vb = 0; vb < NVB; ++vb) { oacc[vb][0] = (f32x4){0.f, 0.f, 0.f, 0.f}; oacc[vb][1] = (f32x4){0.f, 0.f, 0.f, 0.f}; }
    float mrun[2] = {-1e30f, -1e30f}, lrun[2] = {0.f, 0.f};
    u32x4 pk[4], pv[4];
    const int prow = tid >> 5, pc = tid & 31;
    {   const bf16_t* src = H + (rowbase + tile_lo * 64 + prow) * HWID + quad * 256 + pc * 8;
#pragma unroll
        for (int k = 0; k < 4; ++k) { pk[k] = *(const u32x4*)(src + (size_t)k * 16 * HWID + KCOL); pv[k] = *(const u32x4*)(src + (size_t)k * 16 * HWID + VCOL); } }
    const int vcol0 = DA ? (hq >> 1) * 128 : hq * 64;
    for (int tile = tile_lo; tile <= tile_hi; ++tile) {
        __syncthreads();
#pragma unroll
        for (int k = 0; k < 4; ++k) { *(LAS u32x4*)(Kimg + (prow + 16 * k) * RS + pc * 16) = pk[k]; *(LAS u32x4*)(Vimg + (prow + 16 * k) * RS + pc * 16) = pv[k]; }
        __syncthreads();
        if (tile < tile_hi) { const bf16_t* src = H + (rowbase + (tile + 1) * 64 + prow) * HWID + quad * 256 + pc * 8;
#pragma unroll
            for (int k = 0; k < 4; ++k) { pk[k] = *(const u32x4*)(src + (size_t)k * 16 * HWID + KCOL); pv[k] = *(const u32x4*)(src + (size_t)k * 16 * HWID + VCOL); } }
        f32x4 sacc[4][2];
#pragma unroll
        for (int kb = 0; kb < 4; ++kb) { sacc[kb][0] = (f32x4){0.f, 0.f, 0.f, 0.f}; sacc[kb][1] = (f32x4){0.f, 0.f, 0.f, 0.f};
#pragma unroll
            for (int s = 0; s < 2; ++s) { const bf16x8 kf = *(const LAS bf16x8*)(Kimg + (kb * 16 + fr) * RS + (hq * 64 + s * 32 + g * 8) * 2);
                sacc[kb][0] = MFMA16(kf, qf[0][s], sacc[kb][0]); sacc[kb][1] = MFMA16(kf, qf[1][s], sacc[kb][1]); } }
        if (!DA) {
#pragma unroll
            for (int kb = 0; kb < 4; ++kb)
#pragma unroll
                for (int qb = 0; qb < 2; ++qb)
#pragma unroll
                    for (int i = 0; i < 4; ++i) { const int key = tile * 64 + kb * 16 + 4 * g + i, q = t0 + qh * 32 + qb * 16 + fr; int rel = q - key; rel = rel < -256 ? -256 : (rel > 256 ? 256 : rel);
                        sacc[kb][qb][i] += biasLds[hq * 516 + rel + 256]; }
        }
        bf16x8 pf[2][2];
#pragma unroll
        for (int qb = 0; qb < 2; ++qb) {
            float mx = -1e30f;
#pragma unroll
            for (int kb = 0; kb < 4; ++kb)
#pragma unroll
                for (int i = 0; i < 4; ++i) mx = fmaxf(mx, sacc[kb][qb][i]);
            mx = fmaxf(mx, __shfl_xor(mx, 16)); mx = fmaxf(mx, __shfl_xor(mx, 32));
            const float mnew = fmaxf(mrun[qb], mx), alpha = ex2(mrun[qb] - mnew); mrun[qb] = mnew;
            float rs = 0.f;
#pragma unroll
            for (int kb = 0; kb < 4; ++kb)
#pragma unroll
                for (int i = 0; i < 4; ++i) { const float p = ex2(sacc[kb][qb][i] - mnew); sacc[kb][qb][i] = p; rs += p; }
            rs += __shfl_xor(rs, 16); rs += __shfl_xor(rs, 32);
            lrun[qb] = lrun[qb] * alpha + rs;
#pragma unroll
            for (int vb = 0; vb < NVB; ++vb) oacc[vb][qb] = oacc[vb][qb] * alpha;
            pf[qb][0] = pack8(sacc[0][qb], sacc[1][qb]); pf[qb][1] = pack8(sacc[2][qb], sacc[3][qb]);
        }
#pragma unroll
        for (int vb = 0; vb < NVB; ++vb)
#pragma unroll
            for (int s2 = 0; s2 < 2; ++s2) {
                const s16x4 lo = tr_read(Vimg + (32 * s2 + 4 * g + (fr >> 2)) * RS + (vcol0 + 16 * vb + 4 * (fr & 3)) * 2);
                const s16x4 hi = tr_read(Vimg + (32 * s2 + 16 + 4 * g + (fr >> 2)) * RS + (vcol0 + 16 * vb + 4 * (fr & 3)) * 2);
                const bf16x8 vf = cat8(lo, hi);
                oacc[vb][0] = MFMA16(vf, pf[0][s2], oacc[vb][0]); oacc[vb][1] = MFMA16(vf, pf[1][s2], oacc[vb][1]); }
    }
    const float inv0 = 1.0f / lrun[0], inv1 = 1.0f / lrun[1];
    if (!DA) {
#pragma unroll
        for (int qb = 0; qb < 2; ++qb) { const float inv = qb ? inv1 : inv0; bf16_t* dst = Oout + (rowbase + t0 + qh * 32 + qb * 16 + fr) * 512 + (quad * 4 + hq) * 64 + 4 * g;
#pragma unroll
            for (int vb = 0; vb < NVB; ++vb) { const f32x4 o = oacc[vb][qb] * inv; u32x2 w; w.x = cvt_pk_bf16(o[0], o[1]); w.y = cvt_pk_bf16(o[2], o[3]); *(u32x2*)(dst + 16 * vb) = w; } }
    } else {
        __syncthreads();
        LAS float* ex = (LAS float*)lds + ((hq >> 1) * 2 + qh) * 4096 + lane;
        if (hq & 1) {
#pragma unroll
            for (int vb = 0; vb < NVB; ++vb)
#pragma unroll
                for (int qb = 0; qb < 2; ++qb)
#pragma unroll
                    for (int i = 0; i < 4; ++i) ex[((vb * 2 + qb) * 4 + i) * 64] = oacc[vb][qb][i] * (qb ? inv1 : inv0);
        }
        __syncthreads();
        if (!(hq & 1)) {
#pragma unroll
            for (int qb = 0; qb < 2; ++qb) { const float inv = qb ? inv1 : inv0; float ss = 0.f;
#pragma unroll
                for (int vb = 0; vb < NVB; ++vb)
#pragma unroll
                    for (int i = 0; i < 4; ++i) { const float o = oacc[vb][qb][i] * inv - lam * ex[((vb * 2 + qb) * 4 + i) * 64]; oacc[vb][qb][i] = o; ss += o * o; }
                ss += __shfl_xor(ss, 16); ss += __shfl_xor(ss, 32);
                const float r = oscale / sqrtf(ss * (1.0f / 128.0f) + LN_EPS);
                bf16_t* dst = Oout + (rowbase + t0 + qh * 32 + qb * 16 + fr) * 512 + (quad * 2 + (hq >> 1)) * 128 + 4 * g;
#pragma unroll
                for (int vb = 0; vb < NVB; ++vb) { const f32x4 ng = *(const f32x4*)(normg + 16 * vb + 4 * g); const f32x4 o = oacc[vb][qb] * ng * r;
                    u32x2 w; w.x = cvt_pk_bf16(o[0], o[1]); w.y = cvt_pk_bf16(o[2], o[3]); *(u32x2*)(dst + 16 * vb) = w; } }
        }
    }
}

__device__ __forceinline__ void ret_unit(LAS unsigned char* lds, const bf16_t* __restrict__ H, int bl, int h, bf16_t* __restrict__ OA, const float* __restrict__ normg) {
    int tid_ = threadIdx.x; asm volatile("" : "+v"(tid_));
    const int tid = tid_, wid = __builtin_amdgcn_readfirstlane(tid >> 6), lane = tid & 63, fr = lane & 15, g = lane >> 4;
    constexpr int QS = 272, VS = 528, PS = 144;
    LAS unsigned char* Qimg = lds; LAS unsigned char* Kimg = lds + 64 * QS; LAS unsigned char* K2img = lds + 2 * 64 * QS; LAS unsigned char* Vimg = lds + 3 * 64 * QS;
    LAS unsigned char* Pimg = Vimg + 64 * VS; LAS float* part = (LAS float*)(Pimg + 64 * PS);
    const float lg2 = log2f(1.0f - ex2(-5.0f - (float)h));
    const float cd = ex2(lg2 * 64.0f);
    const size_t rowbase = (size_t)bl * SEQ;
    f32x4 st[8][2];
#pragma unroll
    for (int db = 0; db < 8; ++db) { st[db][0] = (f32x4){0.f, 0.f, 0.f, 0.f}; st[db][1] = (f32x4){0.f, 0.f, 0.f, 0.f}; }
    const int qrow = tid >> 4, qc = tid & 15;
    const int vrow = tid >> 5, vc = tid & 31;
    const int rb1 = wid >> 1, ch1 = wid & 1;
    const float ng0 = normg[32 * wid + fr], ng1 = normg[32 * wid + 16 + fr];
    u32x4 pq[2], pk[2], pv[4];
    {   const bf16_t* src = H + rowbase * HWID;
#pragma unroll
        for (int k = 0; k < 2; ++k) { const int r = qrow + 32 * k; pq[k] = *(const u32x4*)(src + (size_t)r * HWID + h * 128 + qc * 8); pk[k] = *(const u32x4*)(src + (size_t)r * HWID + 512 + h * 128 + qc * 8); }
#pragma unroll
        for (int k = 0; k < 4; ++k) pv[k] = *(const u32x4*)(src + (size_t)(vrow + 16 * k) * HWID + 1024 + h * 256 + vc * 8); }
    for (int c = 0; c < 32; ++c) {
        int tl = tid_; asm volatile("" : "+v"(tl));
        const int lane = tl & 63, fr = lane & 15, g = lane >> 4, qrow = tl >> 4, qc = tl & 15, vrow = tl >> 5, vc = tl & 31;
        float lgc = lg2; asm volatile("" : "+v"(lgc));
        __syncthreads();
#pragma unroll
        for (int k = 0; k < 2; ++k) { const int r = qrow + 32 * k;
            *(LAS u32x4*)(Qimg + r * QS + qc * 16) = pq[k]; *(LAS u32x4*)(Kimg + r * QS + qc * 16) = pk[k];
            f32x4 a, b; pg8::unpack8(pk[k], a, b); const float kd = ex2(lgc * (float)(63 - r)); *(LAS bf16x8*)(K2img + r * QS + qc * 16) = pack8(a * kd, b * kd); }
#pragma unroll
        for (int k = 0; k < 4; ++k) *(LAS u32x4*)(Vimg + (vrow + 16 * k) * VS + vc * 16) = pv[k];
        __syncthreads();
        {   f32x4 pa[2] = {(f32x4){0.f, 0.f, 0.f, 0.f}, (f32x4){0.f, 0.f, 0.f, 0.f}};
#pragma unroll
            for (int s = 0; s < 4; ++s) { const bf16x8 qa = *(const LAS bf16x8*)(Qimg + (16 * rb1 + fr) * QS + (32 * s + 8 * g) * 2);
#pragma unroll
                for (int cb = 0; cb < 2; ++cb) { const bf16x8 kbf = *(const LAS bf16x8*)(Kimg + (32 * ch1 + 16 * cb + fr) * QS + (32 * s + 8 * g) * 2); pa[cb] = MFMA16(qa, kbf, pa[cb]); } }
#pragma unroll
            for (int cb = 0; cb < 2; ++cb)
#pragma unroll
                for (int i = 0; i < 4; ++i) { const int n = 16 * rb1 + 4 * g + i, m = 32 * ch1 + 16 * cb + fr; const int d = n > m ? n - m : m - n;
                    *(LAS unsigned short*)(Pimg + n * PS + m * 2) = (unsigned short)f2bf(pa[cb][i] * ex2(lgc * (float)d)); } }
        __syncthreads();
        bf16x8 vfr[2][2];
#pragma unroll
        for (int cb = 0; cb < 2; ++cb)
#pragma unroll
            for (int s2 = 0; s2 < 2; ++s2) { const s16x4 lo = tr_read(Vimg + (32 * s2 + 8 * g + (fr >> 2)) * VS + (32 * wid + 16 * cb + 4 * (fr & 3)) * 2);
                const s16x4 hi = tr_read(Vimg + (32 * s2 + 8 * g + 4 + (fr >> 2)) * VS + (32 * wid + 16 * cb + 4 * (fr & 3)) * 2); vfr[cb][s2] = cat8(lo, hi); }
        f32x4 oa[4][2];
#pragma unroll
        for (int rb = 0; rb < 4; ++rb) { oa[rb][0] = (f32x4){0.f, 0.f, 0.f, 0.f}; oa[rb][1] = (f32x4){0.f, 0.f, 0.f, 0.f}; }
#pragma unroll
        for (int s = 0; s < 4; ++s) { const bf16x8 sb0 = pack8(st[2 * s][0], st[2 * s + 1][0]), sb1 = pack8(st[2 * s][1], st[2 * s + 1][1]);
#pragma unroll
            for (int rb = 0; rb < 4; ++rb) { const s16x4 lo = *(const LAS s16x4*)(Qimg + (16 * rb + fr) * QS + (32 * s + 4 * g) * 2), hi = *(const LAS s16x4*)(Qimg + (16 * rb + fr) * QS + (32 * s + 16 + 4 * g) * 2);
                const bf16x8 qa = cat8(lo, hi); oa[rb][0] = MFMA16(qa, sb0, oa[rb][0]); oa[rb][1] = MFMA16(qa, sb1, oa[rb][1]); } }
#pragma unroll
        for (int rb = 0; rb < 4; ++rb)
#pragma unroll
            for (int i = 0; i < 4; ++i) { const float qd = ex2(lgc * (float)(16 * rb + 4 * g + i + 1)); oa[rb][0][i] *= qd; oa[rb][1][i] *= qd; }
#pragma unroll
        for (int rb = 0; rb < 4; ++rb)
#pragma unroll
            for (int s2 = 0; s2 < 2; ++s2) { const bf16x8 pa = *(const LAS bf16x8*)(Pimg + (16 * rb + fr) * PS + (32 * s2 + 8 * g) * 2);
                oa[rb][0] = MFMA16(pa, vfr[0][s2], oa[rb][0]); oa[rb][1] = MFMA16(pa, vfr[1][s2], oa[rb][1]); }
#pragma unroll
        for (int db = 0; db < 8; ++db) { st[db][0] = st[db][0] * cd; st[db][1] = st[db][1] * cd;
#pragma unroll
            for (int s2 = 0; s2 < 2; ++s2) { const s16x4 lo = tr_read(K2img + (32 * s2 + 8 * g + (fr >> 2)) * QS + (16 * db + 4 * (fr & 3)) * 2);
                const s16x4 hi = tr_read(K2img + (32 * s2 + 8 * g + 4 + (fr >> 2)) * QS + (16 * db + 4 * (fr & 3)) * 2); const bf16x8 ka = cat8(lo, hi);
                st[db][0] = MFMA16(ka, vfr[0][s2], st[db][0]); st[db][1] = MFMA16(ka, vfr[1][s2], st[db][1]); } }
        if (c < 31) { const bf16_t* src = H + (rowbase + (c + 1) * 64) * HWID;
#pragma unroll
            for (int k = 0; k < 2; ++k) { const int r = qrow + 32 * k; pq[k] = *(const u32x4*)(src + (size_t)r * HWID + h * 128 + qc * 8); pk[k] = *(const u32x4*)(src + (size_t)r * HWID + 512 + h * 128 + qc * 8); }
#pragma unroll
            for (int k = 0; k < 4; ++k) pv[k] = *(const u32x4*)(src + (size_t)(vrow + 16 * k) * HWID + 1024 + h * 256 + vc * 8); }
#pragma unroll
        for (int rb = 0; rb < 4; ++rb)
#pragma unroll
            for (int i = 0; i < 4; ++i) { float ss = oa[rb][0][i] * oa[rb][0][i] + oa[rb][1][i] * oa[rb][1][i];
                ss += __shfl_xor(ss, 1); ss += __shfl_xor(ss, 2); ss += __shfl_xor(ss, 4); ss += __shfl_xor(ss, 8);
                if (fr == 0) part[wid * 64 + 16 * rb + 4 * g + i] = ss; }
        u32x4 gt[4];
#pragma unroll
        for (int k = 0; k < 4; ++k) gt[k] = *(const u32x4*)(H + (rowbase + c * 64 + vrow + 16 * k) * HWID + 2048 + h * 256 + vc * 8);
        __syncthreads();
#pragma unroll
        for (int rb = 0; rb < 4; ++rb)
#pragma unroll
            for (int i = 0; i < 4; ++i) { const int n = 16 * rb + 4 * g + i; float tot = 0.f;
#pragma unroll
                for (int w = 0; w < 8; ++w) tot += part[w * 64 + n];
                const float r = 1.0f / sqrtf(tot * (1.0f / 256.0f) + LN_EPS);
                *(LAS unsigned short*)(Vimg + n * VS + (32 * wid + fr) * 2) = (unsigned short)f2bf(oa[rb][0][i] * r * ng0);
                *(LAS unsigned short*)(Vimg + n * VS + (32 * wid + 16 + fr) * 2) = (unsigned short)f2bf(oa[rb][1][i] * r * ng1); }
        __syncthreads();
#pragma unroll
        for (int k = 0; k < 4; ++k) { const int r = vrow + 16 * k; const u32x4 ov = *(const LAS u32x4*)(Vimg + r * VS + vc * 16);
            f32x4 o0, o1, g0, g1; pg8::unpack8(ov, o0, o1); pg8::unpack8(gt[k], g0, g1);
            *(bf16x8*)(OA + (rowbase + c * 64 + r) * 1024 + h * 256 + vc * 8) = pack8(o0 * g0, o1 * g1); }
    }
}

__global__ void __launch_bounds__(512, 2) fwd_kernel(Params P) {
    extern __shared__ __attribute__((aligned(16))) unsigned char lds_raw[];
    LAS unsigned char* lds = (LAS unsigned char*)lds_raw;
    cg::grid_group grid = cg::this_grid();
    const int tid = threadIdx.x, lane = tid & 63, wave = __builtin_amdgcn_readfirstlane(tid >> 6);
    const int NB = gridDim.x, bid = blockIdx.x;
    const int gw = bid * 8 + wave, NGW = NB * 8;
    unsigned char* ws = P.ws;
    const int G = P.G, Mg = G * SEQ, ngrp = NSEQ / G;
    float* tabR = (float*)(ws + WS_TABR); float* tabD = (float*)(ws + WS_TABD);
    bf16_t* WinT = (bf16_t*)(ws + WS_WIN); bf16_t* WaT = (bf16_t*)(ws + WS_WA); bf16_t* WbT = (bf16_t*)(ws + WS_WB); bf16_t* WcT = (bf16_t*)(ws + WS_WC);
    bf16_t* WoT = (bf16_t*)(ws + WS_WO); bf16_t* WfiT = (bf16_t*)(ws + WS_WFI); bf16_t* WfoT = (bf16_t*)(ws + WS_WFO);
    bf16_t* XB = (bf16_t*)(ws + WS_ACT); bf16_t* Hb = XB + (size_t)Mg * 1024; bf16_t* OA = Hb + (size_t)Mg * HWID; bf16_t* OB = OA + (size_t)Mg * 1024; bf16_t* OC = OB + (size_t)Mg * 512;
    bf16_t* ACT = Hb;
    unsigned* qcnt = (unsigned*)(ws + WS_CTL);

    {
        LAS float* scr = (LAS float*)(lds + wave * 16384);
        constexpr int I_IN = 16 * 288, I_A = 16 * 32, I_B = 8 * 32, I_C = 8 * 32, I_O = 16 * 32, I_FI = 16 * 176, I_FO = 44 * 32;
        constexpr int I_L = I_IN + I_A + I_B + I_C + I_O + I_FI + I_FO;
        for (int it = gw; it < DEPTH * I_L; it += NGW) {
            const int l = it / I_L; int r = it - l * I_L;
            if (r < I_IN) { const int kb = r / 288, n0 = 32 * (r % 288); transpose_item(P.in[1] + (size_t)l * 1024 * HWID, 1024, HWID, WinT + (size_t)l * HWID * 1024, scr, kb, n0, map_in(n0), lane); continue; } r -= I_IN;
            if (r < I_A) { const int kb = r / 32, n0 = 32 * (r % 32); transpose_item(P.in[9] + (size_t)l * 1024 * 1024, 1024, 1024, WaT + (size_t)l * 1024 * 1024, scr, kb, n0, n0, lane); continue; } r -= I_A;
            if (r < I_B) { const int kb = r / 32, n0 = 32 * (r % 32); transpose_item(P.in[10] + (size_t)l * 512 * 1024, 512, 1024, WbT + (size_t)l * 1024 * 512, scr, kb, n0, n0, lane); continue; } r -= I_B;
            if (r < I_C) { const int kb = r / 32, n0 = 32 * (r % 32); transpose_item(P.in[11] + (size_t)l * 512 * 1024, 512, 1024, WcT + (size_t)l * 1024 * 512, scr, kb, n0, n0, lane); continue; } r -= I_C;
            if (r < I_O) { const int kb = r / 32, n0 = 32 * (r % 32); transpose_item(P.in[13] + (size_t)l * 1024 * 1024, 1024, 1024, WoT + (size_t)l * 1024 * 1024, scr, kb, n0, n0, lane); continue; } r -= I_O;
            if (r < I_FI) { const int kb = r / 176, n0 = 32 * (r % 176); transpose_item(P.in[16] + (size_t)l * 1024 * 2 * FFH, 1024, 2 * FFH, WfiT + (size_t)l * 2 * FFH * 1024, scr, kb, n0, map_ffn(n0), lane); continue; } r -= I_FI;
            { const int kb = r / 32, n0 = 32 * (r % 32); transpose_item(P.in[17] + (size_t)l * FFH * 1024, FFH, 1024, WfoT + (size_t)l * 1024 * FFH, scr, kb, n0, n0, lane); }
        }
        for (int i = bid * 512 + tid; i < SEQ * 96; i += NB * 512) {
            int pos, j; float invf; float* cdst; float* sdst;
            if (i < SEQ * 64) { pos = i >> 6; j = i & 63; invf = powf(10000.0f, -(float)(2 * j) / 128.0f); cdst = tabR + i; sdst = tabR + SEQ * 64 + i; }
            else { const int i2 = i - SEQ * 64; pos = i2 >> 5; j = i2 & 31; invf = powf(10000.0f, -(float)(2 * j) / 64.0f); cdst = tabD + i2; sdst = tabD + SEQ * 32 + i2; }
            const float ang = (float)pos * invf;
            const double rev = (double)ang * 0.15915494309189535; const float fr_ = (float)(rev - floor(rev));
            *cdst = __builtin_amdgcn_cosf(fr_); *sdst = __builtin_amdgcn_sinf(fr_);
        }
    }
    grid.sync();

    for (int grp = 0; grp < ngrp; ++grp) {
        const size_t goff = (size_t)grp * Mg * 1024;
        float* X = P.out + goff;
        {   const f32x4* src = (const f32x4*)(P.in[0] + goff); u32x2* dst = (u32x2*)XB; int t_ = tid; asm volatile("" : "+v"(t_));
            for (size_t i = (size_t)bid * 512 + t_; i < (size_t)Mg * 256; i += (size_t)NB * 512) { const f32x4 v = src[i]; u32x2 w; w.x = cvt_pk_bf16(v[0], v[1]); w.y = cvt_pk_bf16(v[2], v[3]); dst[i] = w; } }
        grid.sync();
        for (int l = 0; l < DEPTH; ++l) {
            for (int half = 0; half < 2; ++half) {
                if (half == 0) {
                    {   pg8::Gemm gm{XB, WinT + (size_t)l * HWID * 1024, Mg, HWID, 1024}; pg8::StaticOrder S; S.init(Mg, HWID, NB, bid);
                        pg8::EpiIn E{Hb, P.in[12] + l * 3072, tabR, tabD};

#ifndef NO_G1
pg8::gemm_phase<pg8::EpiIn, pg8::StaticOrder, true, true>(lds, gm, S, E);
#endif
 }
                    grid.sync();
#ifdef PROBE_MIX2
                    for (int rep = 0; rep < 2; ++rep)
#else
                    const int rep = 0;
#endif
                    {   const float lambda_init = 0.8f - 0.6f * expf(-0.3f * (float)l);
                        float d1 = 0.f, d2 = 0.f;
                        for (int i = 0; i < 64; ++i) { d1 += P.in[4][l * 64 + i] * P.in[5][l * 64 + i]; d2 += P.in[6][l * 64 + i] * P.in[7][l * 64 + i]; }
                        const float lam = expf(d1) - expf(d2) + lambda_init;
                        const int NR = G * 4, NDA = G * 64, NU = NR + 2 * NDA;
                        volatile LAS int* qslot = (volatile LAS int*)(lds + QSLOT_OFF);
                        for (;;) {
                            __syncthreads();
                            if (tid == 0) *qslot = (int)atomicAdd(qcnt + rep * 64 + grp * DEPTH + l, 1u);
                            __syncthreads();
                            const int u = *qslot;
                            if (u >= NU) break;
                            if (u < NR) {
#ifndef NO_RET
 ret_unit(lds, Hb, u >> 2, u & 3, OA, P.in[2] + l * 256);
#endif
 }
                            else if (u < NR + NDA) { const int v = u - NR; const int chunk = 31 - v / (2 * G), rem = v % (2 * G);
#ifndef NO_DA
 attn_unit<true>(lds, Hb, rem >> 1, chunk, rem & 1, OC, nullptr, lam, 1.0f - lambda_init, P.in[8] + l * 128);
#endif
 }
                            else { const int v = u - NR - NDA; const int chunk = 31 - v / (2 * G), rem = v % (2 * G);
#ifndef NO_CA
 attn_unit<false>(lds, Hb, rem >> 1, chunk, rem & 1, OB, P.in[3] + l * 8 * 513, 0.f, 1.f, nullptr);
#endif
 }
                        }
#ifdef PROBE_MIX2
                        grid.sync();
#endif
                    }
#ifndef PROBE_MIX2
                    grid.sync();
#endif
                    for (int br = 0; br < 3; ++br) {
                        const bf16_t* A = br == 0 ? OA : (br == 1 ? OB : OC); const int K = br == 0 ? 1024 : 512;
                        const bf16_t* Bt = br == 0 ? WaT + (size_t)l * 1024 * 1024 : (br == 1 ? WbT + (size_t)l * 1024 * 512 : WcT + (size_t)l * 1024 * 512);
                        pg8::Gemm gm{A, Bt, Mg, 1024, K}; pg8::StaticOrder S; S.init(Mg, 1024, NB, bid);
                        pg8::EpiBranch E{XB, Hb, br, br == 0};

#ifndef NO_G3
pg8::gemm_phase<pg8::EpiBranch, pg8::StaticOrder, true, true>(lds, gm, S, E);
#endif

                    }
                    grid.sync();
                } else {
                    {   pg8::Gemm gm{XB, WfiT + (size_t)l * 2 * FFH * 1024, Mg, 2 * FFH, 1024}; pg8::StaticOrder S; S.init(Mg, 2 * FFH, NB, bid);
                        pg8::EpiSwiglu E{ACT};

#ifndef NO_G5
pg8::gemm_phase<pg8::EpiSwiglu, pg8::StaticOrder, true, true>(lds, gm, S, E);
#endif
 }
                    grid.sync();
                }
                {   const bf16_t* A = half == 0 ? XB : ACT; const int K = half == 0 ? 1024 : FFH;
                    const bf16_t* Bt = half == 0 ? WoT + (size_t)l * 1024 * 1024 : WfoT + (size_t)l * 1024 * FFH;
                    const float* resid = (half == 0 && l == 0) ? P.in[0] + goff : X;
                    pg8::Gemm gm{A, Bt, Mg, 1024, K}; pg8::StaticOrder S; S.init(Mg, 1024, NB, bid);
                    pg8::EpiResid E{resid, X, ALPHA};

#ifndef NO_G4
pg8::gemm_phase<pg8::EpiResid, pg8::StaticOrder, true, true>(lds, gm, S, E);
#endif
 }
                grid.sync();
                {   const float* gam = (half == 0 ? P.in[14] : P.in[18]) + l * 1024; const float* bet = (half == 0 ? P.in[15] : P.in[19]) + l * 1024;
                    f32x4 gv[4], bv[4]; int lane_ = lane; asm volatile("" : "+v"(lane_));
#define lane lane_
#pragma unroll
                    for (int j = 0; j < 4; ++j) { gv[j] = *((const f32x4*)gam + lane + 64 * j); bv[j] = *((const f32x4*)bet + lane + 64 * j); }
                    for (int m = gw; m < Mg; m += NGW) {
                        f32x4* xr = (f32x4*)(X + (size_t)m * 1024) + lane; f32x4 v[4]; float s = 0.f;
#pragma unroll
                        for (int j = 0; j < 4; ++j) { v[j] = xr[64 * j]; s += (v[j][0] + v[j][1]) + (v[j][2] + v[j][3]); }
                        const float mean = wave_sum(s) * (1.0f / 1024.0f); float s2 = 0.f;
#pragma unroll
                        for (int j = 0; j < 4; ++j) { v[j] = v[j] - mean; s2 += (v[j][0] * v[j][0] + v[j][1] * v[j][1]) + (v[j][2] * v[j][2] + v[j][3] * v[j][3]); }
                        const float rstd = 1.0f / sqrtf(wave_sum(s2) * (1.0f / 1024.0f) + LN_EPS);
                        u32x2* o8 = (u32x2*)(XB + (size_t)m * 1024) + lane;
#pragma unroll
                        for (int j = 0; j < 4; ++j) { const f32x4 y = v[j] * rstd * gv[j] + bv[j]; xr[64 * j] = y; u32x2 w; w.x = cvt_pk_bf16(y[0], y[1]); w.y = cvt_pk_bf16(y[2], y[3]); o8[64 * j] = w; }
                    }
#undef lane
                }
                grid.sync();
            }
        }
    }
}

extern "C" void kernel_launch(void* const* d_in, const int* in_sizes, int n_in, void* d_out, int out_size, void* d_ws, size_t ws_size, hipStream_t stream) {
    static int grid_blocks = 0;
    if (grid_blocks == 0) {
        int dev = 0, cus = 0, per_cu = 0;
        hipGetDevice(&dev); hipDeviceGetAttribute(&cus, hipDeviceAttributeMultiprocessorCount, dev);
        hipFuncSetAttribute((const void*)fwd_kernel, hipFuncAttributeMaxDynamicSharedMemorySize, LDS_BYTES);
        hipOccupancyMaxActiveBlocksPerMultiprocessor(&per_cu, (const void*)fwd_kernel, 512, LDS_BYTES);
        if (per_cu < 1) per_cu = 1;
        grid_blocks = cus;
        (void)hipGetLastError();
    }
    int G = 16;
    while (G > 1 && WS_ACT + (size_t)G * SEQ * 24576 > ws_size) G >>= 1;
    hipMemsetAsync(d_ws, 0, 4096, stream);
    Params p{};
    for (int i = 0; i < 20; ++i) p.in[i] = (const float*)d_in[i];
    p.out = (float*)d_out; p.ws = (unsigned char*)d_ws; p.G = G; p.pad = 0;
    void* args[] = {&p};
    hipError_t e = hipLaunchCooperativeKernel((const void*)fwd_kernel, dim3(grid_blocks), dim3(512), args, LDS_BYTES, stream);
    if (e != hipSuccess) fprintf(stderr, "cooperative launch failed: %s (grid %d)\n", hipGetErrorString(e), grid_blocks);
}
```

```cpp
#include <hip/hip_runtime.h>
#include <hip/hip_cooperative_groups.h>
#include <cstdio>
#include <cstdint>
#include <cmath>
namespace cg = cooperative_groups;
namespace pg8 {
#define PG8_LAS __attribute__((address_space(3)))
typedef unsigned short bf16_t;
typedef short bf16x8 __attribute__((ext_vector_type(8)));
typedef float f32x4 __attribute__((ext_vector_type(4)));
typedef unsigned u32x4 __attribute__((ext_vector_type(4)));
constexpr int BM = 256, BK = 64, HALF = 128, HTB = HALF * BK * 2  , STAGE_BYTES = 8 * HTB, NXCD = 8, WGM = 8;

__host__ __device__ __forceinline__ int lds_byte(int r, int c) { const int st = (r >> 4) * 2 + (c >> 5), rr = r & 15, cc = c & 31, ob = rr * 64 + cc * 2; return st * 1024 + (ob ^ (((ob >> 9) & 1) << 5)); }
__host__ __device__ __forceinline__ void stage_rc(int b, int& R, int& C) { const int st = b / 1024, sb = b % 1024, swz = sb ^ (((sb >> 9) & 1) << 5); R = (st >> 1) * 16 + swz / 64; C = (st & 1) * 32 + (swz % 64) / 2; }
__host__ __device__ __forceinline__ int perm32(int rho) { const int n = rho >> 4, i = rho & 15; return 8 * (i >> 2) + 4 * n + (i & 3); }

struct Unit { int pm, pn; };
struct Gemm { const bf16_t* A; const bf16_t* Bt; int M, N, K; };

struct StaticOrder {
    int nM, nN, nwg, G, c;
    __host__ __device__ void init(int M, int N, int G_, int c_) { nM = M / BM; nN = N / BM; nwg = nM * nN; G = G_; c = c_; }
    __host__ __device__ bool next(int i, Unit& u) const {
        const long L = (long)i * G + c; if (L >= nwg) return false;
        int wgid = (int)L; { const int q = nwg / NXCD, r = nwg % NXCD, xcd = wgid % NXCD, off = wgid / NXCD; wgid = (xcd < r ? xcd * (q + 1) : r * (q + 1) + (xcd - r) * q) + off; }
        const int nig = WGM * nN, gid = wgid / nig, fm = gid * WGM, gsz = (nM - fm) < WGM ? (nM - fm) : WGM;
        u.pm = fm + ((wgid % nig) % gsz); u.pn = (wgid % nig) / gsz; return true;
    }
    __device__ __forceinline__ void a_ready(const Unit&) const {}
    __device__ __forceinline__ void done(const Unit&) const {}
};

__device__ __forceinline__ unsigned cvt_pk_bf16(float lo, float hi) { unsigned r; asm volatile("v_cvt_pk_bf16_f32 %0, %1, %2" : "=v"(r) : "v"(lo), "v"(hi)); return r; }
__device__ __forceinline__ void store16(bf16_t* dst, const f32x4 a, const f32x4 b) {
    u32x4 w; w.x = cvt_pk_bf16(a[0], a[1]); w.y = cvt_pk_bf16(a[2], a[3]); w.z = cvt_pk_bf16(b[0], b[1]); w.w = cvt_pk_bf16(b[2], b[3]); *(u32x4*)dst = w;
}
__device__ __forceinline__ float fast_sigmoid(float x) { return __builtin_amdgcn_rcpf(1.0f + __builtin_amdgcn_exp2f(-1.4426950408889634f * x)); }
__device__ __forceinline__ f32x4 silu4(f32x4 v) { f32x4 r; r[0] = v[0] * fast_sigmoid(v[0]); r[1] = v[1] * fast_sigmoid(v[1]); r[2] = v[2] * fast_sigmoid(v[2]); r[3] = v[3] * fast_sigmoid(v[3]); return r; }
__device__ __forceinline__ f32x4 sigm4(f32x4 v) { f32x4 r; r[0] = fast_sigmoid(v[0]); r[1] = fast_sigmoid(v[1]); r[2] = fast_sigmoid(v[2]); r[3] = fast_sigmoid(v[3]); return r; }
__device__ __forceinline__ void unpack8(const u32x4 w, f32x4& a, f32x4& b) {
    a[0] = __uint_as_float(w.x << 16); a[1] = __uint_as_float(w.x & 0xffff0000u); a[2] = __uint_as_float(w.y << 16); a[3] = __uint_as_float(w.y & 0xffff0000u);
    b[0] = __uint_as_float(w.z << 16); b[1] = __uint_as_float(w.z & 0xffff0000u); b[2] = __uint_as_float(w.w << 16); b[3] = __uint_as_float(w.w & 0xffff0000u);
}
constexpr int HWID = 9216;
constexpr float C2F = 0.125f * 1.4426950408889634f;

struct EpiIn {
    static constexpr bool PERM = true, AFTER_DRAIN = false;
    bf16_t* H; const float* bmerge; const float* tabR; const float* tabD;
    __device__ __forceinline__ void operator()(const f32x4 (&acc)[2][2][4][2], const Unit& u, int wr, int wc, int fr, int fq) const {
        const int pn = u.pn; const int row0 = u.pm * BM + wr * 64 + fr; const int q0 = wc * 32 + 8 * fq;
        if (pn < 4) {
            const float sc = pn >= 2 ? 0.08838834764831845f : 1.0f; const int head = q0 >> 6, i0 = q0 & 63;
#pragma unroll
            for (int ai = 0; ai < 2; ++ai)
#pragma unroll
                for (int m = 0; m < 4; ++m) { const int row = row0 + ai * HALF + m * 16; const int pos = row & 2047;
                    const float* cp = tabR + pos * 64 + i0; const float* sp = cp + 2048 * 64;
                    const f32x4 c0 = *(const f32x4*)cp, c1 = *(const f32x4*)(cp + 4), s0 = *(const f32x4*)sp, s1 = *(const f32x4*)(sp + 4);
                    const f32x4 x1a = acc[ai][0][m][0], x1b = acc[ai][0][m][1], x2a = acc[ai][1][m][0], x2b = acc[ai][1][m][1];
                    bf16_t* dst = H + (size_t)row * HWID + pn * 256 + head * 128 + i0;
                    store16(dst, (x1a * c0 - x2a * s0) * sc, (x1b * c1 - x2b * s1) * sc);
                    store16(dst + 64, (x2a * c0 + x1a * s0) * sc, (x2b * c1 + x1b * s1) * sc); asm volatile("" ::: "memory"); }
        } else if (pn >= 18 && pn < 22) {
            const float sc = pn < 20 ? C2F : 1.0f; const int head = q0 >> 5, i0 = q0 & 31;
#pragma unroll
            for (int ai = 0; ai < 2; ++ai)
#pragma unroll
                for (int m = 0; m < 4; ++m) { const int row = row0 + ai * HALF + m * 16; const int pos = row & 2047;
                    const float* cp = tabD + pos * 32 + i0; const float* sp = cp + 2048 * 32;
                    const f32x4 c0 = *(const f32x4*)cp, c1 = *(const f32x4*)(cp + 4), s0 = *(const f32x4*)sp, s1 = *(const f32x4*)(sp + 4);
                    const f32x4 x1a = acc[ai][0][m][0], x1b = acc[ai][0][m][1], x2a = acc[ai][1][m][0], x2b = acc[ai][1][m][1];
                    bf16_t* dst = H + (size_t)row * HWID + pn * 256 + head * 64 + i0;
                    store16(dst, (x1a * c0 - x2a * s0) * sc, (x1b * c1 - x2b * s1) * sc);
                    store16(dst + 32, (x2a * c0 + x1a * s0) * sc, (x2b * c1 + x1b * s1) * sc); asm volatile("" ::: "memory"); }
        } else {
            const int mode = (pn >= 24) ? 2 : ((pn >= 8 && pn < 12) ? 1 : 0); const float sc = (pn == 12 || pn == 13) ? C2F : 1.0f;
#pragma unroll
            for (int bj = 0; bj < 2; ++bj) { const int c = pn * 256 + bj * HALF + q0;
                f32x4 b0 = (f32x4){0.f, 0.f, 0.f, 0.f}, b1 = b0;
                if (mode == 2) { b0 = *(const f32x4*)(bmerge + (c - 6144)); b1 = *(const f32x4*)(bmerge + (c - 6144) + 4); }
#pragma unroll
                for (int ai = 0; ai < 2; ++ai)
#pragma unroll
                    for (int m = 0; m < 4; ++m) { const int row = row0 + ai * HALF + m * 16;
                        f32x4 v0 = acc[ai][bj][m][0], v1 = acc[ai][bj][m][1]; asm volatile("" : "+v"(v0), "+v"(v1));
                        if (mode == 2) { v0 = sigm4(v0 + b0); v1 = sigm4(v1 + b1); } else if (mode == 1) { v0 = silu4(v0); v1 = silu4(v1); } else { v0 = v0 * sc; v1 = v1 * sc; }
                        store16(H + (size_t)row * HWID + c, v0, v1); asm volatile("" ::: "memory"); } }
        }
    }
};
struct EpiBranch {
    static constexpr bool PERM = true, AFTER_DRAIN = false;
    bf16_t* Mg; const bf16_t* H; int gsel; int first;
    __device__ __forceinline__ void operator()(const f32x4 (&acc)[2][2][4][2], const Unit& u, int wr, int wc, int fr, int fq) const {
        const int row0 = u.pm * BM + wr * 64 + fr; const int q0 = wc * 32 + 8 * fq;
#pragma unroll
        for (int ai = 0; ai < 2; ++ai)
#pragma unroll
            for (int m = 0; m < 4; ++m) { const int row = row0 + ai * HALF + m * 16;
#pragma unroll
                for (int bj = 0; bj < 2; ++bj) { const int c = u.pn * 256 + bj * HALF + q0;
                    f32x4 g0, g1; unpack8(*(const u32x4*)(H + (size_t)row * HWID + 6144 + gsel * 1024 + c), g0, g1);
                    f32x4 v0 = g0 * acc[ai][bj][m][0], v1 = g1 * acc[ai][bj][m][1];
                    bf16_t* dst = Mg + (size_t)row * 1024 + c;
                    if (!first) { f32x4 o0, o1; unpack8(*(const u32x4*)dst, o0, o1); v0 = v0 + o0; v1 = v1 + o1; }
                    store16(dst, v0, v1); } asm volatile("" ::: "memory"); }
    }
};
struct EpiResid {
    static constexpr bool PERM = true, AFTER_DRAIN = false;
    const float* resid; float* Y; float alpha;
    __device__ __forceinline__ void operator()(const f32x4 (&acc)[2][2][4][2], const Unit& u, int wr, int wc, int fr, int fq) const {
        const int row0 = u.pm * BM + wr * 64 + fr; const int q0 = wc * 32 + 8 * fq;
#pragma unroll
        for (int ai = 0; ai < 2; ++ai)
#pragma unroll
            for (int m = 0; m < 4; ++m) { const int row = row0 + ai * HALF + m * 16;
#pragma unroll
                for (int bj = 0; bj < 2; ++bj) { const size_t p = (size_t)row * 1024 + u.pn * 256 + bj * HALF + q0;
                    const f32x4 r0 = *(const f32x4*)(resid + p), r1 = *(const f32x4*)(resid + p + 4);
                    *(f32x4*)(Y + p) = r0 * alpha + acc[ai][bj][m][0]; *(f32x4*)(Y + p + 4) = r1 * alpha + acc[ai][bj][m][1]; } asm volatile("" ::: "memory"); }
    }
};
struct EpiSwiglu {
    static constexpr bool PERM = true, AFTER_DRAIN = false;
    bf16_t* A;
    __device__ __forceinline__ void operator()(const f32x4 (&acc)[2][2][4][2], const Unit& u, int wr, int wc, int fr, int fq) const {
        const int row0 = u.pm * BM + wr * 64 + fr; const int q0 = wc * 32 + 8 * fq;
#pragma unroll
        for (int ai = 0; ai < 2; ++ai)
#pragma unroll
            for (int m = 0; m < 4; ++m) { const int row = row0 + ai * HALF + m * 16;
                f32x4 g0 = acc[ai][0][m][0], g1 = acc[ai][0][m][1]; asm volatile("" : "+v"(g0), "+v"(g1));
                store16(A + (size_t)row * 2816 + u.pn * 128 + q0, silu4(g0) * acc[ai][1][m][0], silu4(g1) * acc[ai][1][m][1]); asm volatile("" ::: "memory"); }
    }
};
template <class Epi, class Sched, bool ALIGN_EPI = false, bool SP2 = false>
__device__ __forceinline__ void gemm_phase(PG8_LAS unsigned char* lds, const Gemm g, const Sched& S, const Epi& E) {
    int tid_ = threadIdx.x; asm volatile("" : "+v"(tid_));
    const int tid = tid_, wid = __builtin_amdgcn_readfirstlane(tid >> 6), lane = tid & 63, wr = wid >> 2, wc = wid & 3, fr = lane & 15, fq = lane >> 4;
    const int K = g.K, nt = K / BK;
    unsigned voffA[2], voffB[2];
#pragma unroll
    for (int i = 0; i < 2; ++i) { int R, C; stage_rc(tid * 16 + i * 8192, R, C); const int Rb = Epi::PERM ? ((R & ~31) + perm32(R & 31)) : R;
        voffA[i] = (unsigned)(R * K + C) * 2u; voffB[i] = (unsigned)(Rb * K + C) * 2u; }
    const size_t kstep = (size_t)(BK * 2);
    const size_t hstep = (size_t)HALF * K * 2;
    const size_t tstep = 2 * hstep;
    const unsigned ldsw = (unsigned)wid * 1024u;
    const int aoff = lds_byte(wr * 64 + fr, fq * 8), boff = lds_byte(wc * 32 + fr, fq * 8);
#define PG8_SA(b, h) (((b) * 2 + (h)) * HTB)
#define PG8_SB(b, h) ((4 + (b) * 2 + (h)) * HTB)
#define PG8_STAGE(bufoff, gbase, voff) do { _Pragma("unroll") for (int _i = 0; _i < 2; ++_i) \
        __builtin_amdgcn_global_load_lds((const unsigned*)((const char*)(gbase) + (voff)[_i]), (PG8_LAS unsigned*)(lds + (bufoff) + ldsw + _i * 8192), 16, 0, 0); } while (0)
#define PG8_LDA(dst, b, h) do { _Pragma("unroll") for (int m = 0; m < 4; ++m) _Pragma("unroll") for (int k = 0; k < 2; ++k) dst[m][k] = *(const PG8_LAS bf16x8*)(lds + PG8_SA(b, h) + aoff + m * 2048 + k * 1024); } while (0)
#define PG8_LDB(dst, b, h) do { _Pragma("unroll") for (int n = 0; n < 2; ++n) _Pragma("unroll") for (int k = 0; k < 2; ++k) dst[n][k] = *(const PG8_LAS bf16x8*)(lds + PG8_SB(b, h) + boff + n * 2048 + k * 1024); } while (0)
#define PG8_MMA(ai, bj, At, Bt) do { __builtin_amdgcn_s_setprio(1); _Pragma("unroll") for (int m = 0; m < 4; ++m) _Pragma("unroll") for (int n = 0; n < 2; ++n) _Pragma("unroll") for (int k = 0; k < 2; ++k) \
        acc[ai][bj][m][n] = __builtin_amdgcn_mfma_f32_16x16x32_bf16(Bt[n][k], At[m][k], acc[ai][bj][m][n], 0, 0, 0); __builtin_amdgcn_s_setprio(0); } while (0)
#define PG8_WAIT_V(n) asm volatile("s_waitcnt vmcnt(" #n ")" ::: "memory")
#define PG8_WAIT_L(n) asm volatile("s_waitcnt lgkmcnt(" #n ")" ::: "memory")
#define PG8_BAR __builtin_amdgcn_s_barrier()
#define PG8_SCHED __builtin_amdgcn_sched_barrier(0)
    Unit cur, nxt; int ui = 0;
    if (!S.next(0, cur)) return;
    f32x4 acc[2][2][4][2];
#pragma unroll
    for (int a = 0; a < 2; ++a)
#pragma unroll
        for (int b = 0; b < 2; ++b)
#pragma unroll
            for (int m = 0; m < 4; ++m)
#pragma unroll
                for (int n = 0; n < 2; ++n) acc[a][b][m][n] = (f32x4){0.f, 0.f, 0.f, 0.f};
    bf16x8 At[4][2], B0[2][2], B1[2][2];
    const char* cA = (const char*)g.A + (size_t)cur.pm * tstep; const char* cB = (const char*)g.Bt + (size_t)cur.pn * tstep;
    S.a_ready(cur);
    if constexpr (SP2) {
        PG8_STAGE(PG8_SB(0, 0), cB, voffB); PG8_STAGE(PG8_SB(0, 1), cB + hstep, voffB); PG8_STAGE(PG8_SA(0, 0), cA, voffA); PG8_STAGE(PG8_SA(0, 1), cA + hstep, voffA);
        if (wr == 1) PG8_BAR;
        PG8_WAIT_V(2); PG8_BAR;
        PG8_STAGE(PG8_SB(1, 0), cB + kstep, voffB); PG8_STAGE(PG8_SA(1, 0), cA + kstep, voffA); PG8_STAGE(PG8_SB(1, 1), cB + hstep + kstep, voffB);
        PG8_WAIT_V(6); PG8_BAR;
    } else {
        PG8_STAGE(PG8_SB(0, 0), cB, voffB); PG8_STAGE(PG8_SA(0, 0), cA, voffA); PG8_STAGE(PG8_SB(0, 1), cB + hstep, voffB); PG8_STAGE(PG8_SA(0, 1), cA + hstep, voffA);
        if (wr == 1) PG8_BAR;
        PG8_WAIT_V(4); PG8_BAR;
        PG8_STAGE(PG8_SB(1, 0), cB + kstep, voffB); PG8_STAGE(PG8_SA(1, 0), cA + kstep, voffA); PG8_STAGE(PG8_SB(1, 1), cB + hstep + kstep, voffB);
        PG8_WAIT_V(6); PG8_BAR;
    }
    for (;;) {
        const bool has_next = S.next(ui + 1, nxt);
        const char* nA = has_next ? (const char*)g.A + (size_t)nxt.pm * tstep : cA; const char* nB = has_next ? (const char*)g.Bt + (size_t)nxt.pn * tstep : cB;
        for (int t = 0; t < nt; t += 2) {
            const bool last = (t == nt - 2);
            const char* a1 = cA + (size_t)(t + 1) * kstep;
            const char* a2 = last ? nA : cA + (size_t)(t + 2) * kstep; const char* b2 = last ? nB : cB + (size_t)(t + 2) * kstep;
            const char* a3 = a2 + kstep; const char* b3 = b2 + kstep;
            if (last && has_next) S.a_ready(nxt);
            if constexpr (SP2) {
            PG8_LDB(B0, 0, 0); PG8_LDB(B1, 0, 1); PG8_SCHED; PG8_LDA(At, 0, 0); PG8_STAGE(PG8_SA(1, 1), a1 + hstep, voffA);
            PG8_WAIT_V(8); PG8_WAIT_L(0); PG8_BAR; PG8_MMA(0, 0, At, B0); PG8_MMA(0, 1, At, B1); PG8_BAR; PG8_SCHED;
            PG8_LDA(At, 0, 1); PG8_STAGE(PG8_SB(0, 0), b2, voffB); PG8_STAGE(PG8_SB(0, 1), b2 + hstep, voffB); PG8_STAGE(PG8_SA(0, 0), a2, voffA);
            PG8_WAIT_V(8); PG8_WAIT_L(0); PG8_BAR; PG8_MMA(1, 0, At, B0); PG8_MMA(1, 1, At, B1); PG8_BAR; PG8_SCHED;
            PG8_LDB(B0, 1, 0); PG8_LDB(B1, 1, 1); PG8_SCHED; PG8_LDA(At, 1, 0); PG8_STAGE(PG8_SA(0, 1), a2 + hstep, voffA);
            PG8_WAIT_V(8); PG8_WAIT_L(0); PG8_BAR; PG8_MMA(0, 0, At, B0); PG8_MMA(0, 1, At, B1); PG8_BAR; PG8_SCHED;
            PG8_LDA(At, 1, 1); PG8_STAGE(PG8_SB(1, 0), b3, voffB); PG8_STAGE(PG8_SB(1, 1), b3 + hstep, voffB); PG8_STAGE(PG8_SA(1, 0), a3, voffA);
            PG8_WAIT_V(8); PG8_WAIT_L(0); PG8_BAR; PG8_MMA(1, 0, At, B0); PG8_MMA(1, 1, At, B1); PG8_BAR; PG8_SCHED;
            } else {
            PG8_LDB(B0, 0, 0); PG8_SCHED; PG8_LDA(At, 0, 0); PG8_STAGE(PG8_SA(1, 1), a1 + hstep, voffA);
            PG8_WAIT_L(8); PG8_BAR; PG8_WAIT_L(0); PG8_MMA(0, 0, At, B0); PG8_BAR; PG8_SCHED;
            PG8_LDB(B1, 0, 1); PG8_STAGE(PG8_SB(0, 0), b2, voffB);
            PG8_BAR; PG8_WAIT_L(0); PG8_MMA(0, 1, At, B1); PG8_BAR;
            PG8_LDA(At, 0, 1); PG8_STAGE(PG8_SA(0, 0), a2, voffA);
            PG8_BAR; PG8_WAIT_L(0); PG8_MMA(1, 0, At, B0); PG8_BAR; PG8_SCHED;
            PG8_STAGE(PG8_SB(0, 1), b2 + hstep, voffB);
            PG8_WAIT_V(6); PG8_BAR; PG8_MMA(1, 1, At, B1); PG8_BAR;
            PG8_LDB(B0, 1, 0); PG8_SCHED; PG8_LDA(At, 1, 0); PG8_STAGE(PG8_SA(0, 1), a2 + hstep, voffA);
            PG8_WAIT_L(8); PG8_BAR; PG8_WAIT_L(0); PG8_MMA(0, 0, At, B0); PG8_BAR; PG8_SCHED;
            PG8_LDB(B1, 1, 1); PG8_STAGE(PG8_SB(1, 0), b3, voffB);
            PG8_BAR; PG8_WAIT_L(0); PG8_MMA(0, 1, At, B1); PG8_BAR;
            PG8_LDA(At, 1, 1); PG8_STAGE(PG8_SA(1, 0), a3, voffA);
            PG8_BAR; PG8_WAIT_L(0); PG8_MMA(1, 0, At, B0); PG8_BAR; PG8_SCHED;
            PG8_STAGE(PG8_SB(1, 1), b3 + hstep, voffB);
            PG8_WAIT_V(6); PG8_BAR; PG8_MMA(1, 1, At, B1); PG8_BAR;
            }
        }
        if constexpr (ALIGN_EPI) { if (wr == 0) PG8_BAR; }
        if constexpr (!Epi::AFTER_DRAIN) { E(acc, cur, wr, wc, fr, fq); S.done(cur); }
        if (!has_next) break;
#pragma unroll
        for (int a = 0; a < 2; ++a)
#pragma unroll
            for (int b = 0; b < 2; ++b)
#pragma unroll
                for (int m = 0; m < 4; ++m)
#pragma unroll
                    for (int n = 0; n < 2; ++n) acc[a][b][m][n] = (f32x4){0.f, 0.f, 0.f, 0.f};
        cur = nxt; cA = nA; cB = nB; ++ui;
        if constexpr (ALIGN_EPI) { if (wr == 1) PG8_BAR; }
    }
    PG8_WAIT_V(0);
    if constexpr (!ALIGN_EPI) { if (wr == 0) PG8_BAR; }
    PG8_BAR;
    if constexpr (Epi::AFTER_DRAIN) { E.fused(acc, cur, wr, wc, fr, fq, lds, wid, lane); S.done(cur); }
#undef PG8_SA
#undef PG8_SB
#undef PG8_STAGE
#undef PG8_LDA
#undef PG8_LDB
#undef PG8_MMA
#undef PG8_WAIT_V
#undef PG8_WAIT_L
#undef PG8_BAR
#undef PG8_SCHED
}
}
#define LAS __attribute__((address_space(3)))
using pg8::bf16_t; using pg8::bf16x8; using pg8::f32x4; using pg8::u32x4; using pg8::cvt_pk_bf16;
typedef short s16x4 __attribute__((ext_vector_type(4)));
typedef unsigned u32x2 __attribute__((ext_vector_type(2)));
constexpr int SEQ = 2048, DM = 1024, NTOK = 65536, DEPTH = 4, HWID = pg8::HWID, FFH = 2816, NSEQ = 32;
constexpr float LOG2E = 1.4426950408889634f;
constexpr float ALPHA = 1.681792830507429f;
constexpr float LN_EPS = 1e-5f;
constexpr size_t MiB = (size_t)1 << 20;
constexpr size_t WS_CTL = 0, WS_TABR = 1 * MiB, WS_TABD = 2 * MiB, WS_WIN = 4 * MiB, WS_WA = 76 * MiB, WS_WB = 84 * MiB, WS_WC = 88 * MiB, WS_WO = 92 * MiB,
                 WS_WFI = 100 * MiB, WS_WFO = 144 * MiB, WS_ACT = 168 * MiB;
constexpr int LDS_BYTES = 147456, QSLOT_OFF = 143360;

struct Params { const float* in[20]; float* out; unsigned char* ws; int G; int pad; };

#define MFMA16(a, b, c) __builtin_amdgcn_mfma_f32_16x16x32_bf16((a), (b), (c), 0, 0, 0)
__device__ __forceinline__ s16x4 tr_read(LAS unsigned char* p) { return __builtin_bit_cast(s16x4, __builtin_amdgcn_ds_read_tr16_b64_v4i16((LAS s16x4*)p)); }
__device__ __forceinline__ bf16x8 cat8(s16x4 lo, s16x4 hi) { return __builtin_shufflevector(lo, hi, 0, 1, 2, 3, 4, 5, 6, 7); }
__device__ __forceinline__ bf16x8 pack8(const f32x4 a, const f32x4 b) { u32x4 w; w.x = cvt_pk_bf16(a[0], a[1]); w.y = cvt_pk_bf16(a[2], a[3]); w.z = cvt_pk_bf16(b[0], b[1]); w.w = cvt_pk_bf16(b[2], b[3]); return __builtin_bit_cast(bf16x8, w); }
__device__ __forceinline__ float ex2(float x) { return __builtin_amdgcn_exp2f(x); }
__device__ __forceinline__ float wave_sum(float v) {
#pragma unroll
    for (int o = 1; o < 64; o <<= 1) v += __shfl_xor(v, o);
    return v;
}
__device__ __forceinline__ unsigned f2bf(float f) { unsigned u = __float_as_uint(f); return (u + 0x7fffu + ((u >> 16) & 1u)) >> 16; }
__device__ __forceinline__ unsigned pk2(float lo, float hi) { return f2bf(lo) | (f2bf(hi) << 16); }

__device__ __forceinline__ int map_in(int n0) { const int t = n0 >> 8, p = n0 & 255;
    if (t < 4) return 256 * t + ((p & 127) >> 6) * 128 + (p >> 7) * 64 + (p & 63);
    if (t >= 18 && t < 22) return 256 * t + ((p & 127) >> 5) * 64 + (p >> 7) * 32 + (p & 31);
    return n0; }
__device__ __forceinline__ int map_ffn(int n0) { const int t = n0 >> 8, p = n0 & 255; return p < 128 ? 128 * t + p : FFH + 128 * t + (p - 128); }

__device__ __forceinline__ void transpose_item(const float* W, int K, int N, bf16_t* WT, LAS float* scr, int kb, int n0, int nsrc, int lane) {
    const int k0 = 64 * kb;
#pragma unroll 8
    for (int i = 0; i < 32; ++i) { const int kk = 2 * i + (lane >> 5); scr[kk * 33 + (lane & 31)] = W[(size_t)(k0 + kk) * N + nsrc + (lane & 31)]; }
    asm volatile("s_waitcnt lgkmcnt(0)" ::: "memory");
    const int c = lane & 7;
#pragma unroll
    for (int j = 0; j < 4; ++j) { const int n = (lane >> 3) + 8 * j; const LAS float* s = scr + (8 * c) * 33 + n;
        u32x4 o; o.x = pk2(s[0 * 33], s[1 * 33]); o.y = pk2(s[2 * 33], s[3 * 33]); o.z = pk2(s[4 * 33], s[5 * 33]); o.w = pk2(s[6 * 33], s[7 * 33]);
        *(u32x4*)(WT + (size_t)(n0 + n) * K + k0 + 8 * c) = o; }
    asm volatile("s_waitcnt lgkmcnt(0)" ::: "memory");
}

#define XB_TMO      128
#define XB_XCNT(j)  (256  + 64 * (j))
#define XB_XSUB(j)  (1280 + 64 * (j))
#define XB_XGEN(j)  (2304 + 64 * (j))
#define XB_TOP      3328
#define XB_TOPGEN   3392
#define XCD_BAR_WORDS 3456
#define XB_SPIN_CAP (1u << 18)

__device__ __forceinline__ unsigned xb_ld(unsigned* p)              { return __hip_atomic_load(p, __ATOMIC_RELAXED, __HIP_MEMORY_SCOPE_AGENT); }
__device__ __forceinline__ unsigned xb_add(unsigned* p, unsigned v) { return __hip_atomic_fetch_add(p, v, __ATOMIC_RELAXED, __HIP_MEMORY_SCOPE_AGENT); }
__device__ __forceinline__ unsigned xb_xcc_id() { return (unsigned)__builtin_amdgcn_s_getreg((3 << 11) | 20) & 0xFu; }
#define XB_SPIN(cond, bar) do { unsigned _sp = 0; while (cond) { __builtin_amdgcn_s_sleep(1); \
    if ((++_sp & 255u) == 0u) { if (xb_ld(&(bar)[XB_TMO])) break; if (_sp > XB_SPIN_CAP) { atomicAdd(&(bar)[XB_TMO], 1u); break; } } } } while (0)

struct XcdBarrier {
    unsigned* bar; unsigned x;
    volatile LAS unsigned* st;
};

__device__ __forceinline__ XcdBarrier xcd_barrier_post(unsigned* bar, volatile LAS unsigned* st) {
    XcdBarrier b; b.bar = bar; b.x = xb_xcc_id(); b.st = st;
    if (threadIdx.x == 0) (void)xb_add(&bar[XB_XCNT(b.x)], 1u);
    return b;
}
__device__ __forceinline__ void xcd_barrier_complete(unsigned* bar, unsigned x, unsigned& nloc, unsigned& nx) {
    const unsigned G = gridDim.x * gridDim.y * gridDim.z;
    unsigned sum, cnt, mine, sp = 0u;
    for (;;) {
        sum = 0u; cnt = 0u; mine = 0u;
#pragma unroll
        for (unsigned j = 0; j < 16; ++j) { const unsigned c = xb_ld(&bar[XB_XCNT(j)]); sum += c; cnt += (c > 0u) ? 1u : 0u; mine = (j == x) ? c : mine; }
        if (sum == G) break;
        __builtin_amdgcn_s_sleep(1);
        if ((++sp & 255u) == 0u) { if (xb_ld(&bar[XB_TMO])) break; if (sp > XB_SPIN_CAP) { atomicAdd(&bar[XB_TMO], 1u); break; } }
    }
    nloc = mine > 0u ? mine : 1u; nx = cnt > 0u ? cnt : 1u;
}

__device__ __forceinline__ void xcd_barrier(const XcdBarrier& b) {
    asm volatile("s_waitcnt vmcnt(0)" ::: "memory");
    __syncthreads();
    if (threadIdx.x == 0) {
        unsigned* bar = b.bar;
        __builtin_amdgcn_s_waitcnt(0);
        unsigned nloc = b.st[0], nx = b.st[1];
        if (nloc == 0u) { xcd_barrier_complete(bar, b.x, nloc, nx); b.st[0] = nloc; b.st[1] = nx; }
        const unsigned old = xb_add(&bar[XB_XSUB(b.x)], 1u);
        const unsigned gen = old / nloc;
        if (old + 1u == (gen + 1u) * nloc) {
            __builtin_amdgcn_fence(__ATOMIC_RELEASE, "agent");
            asm volatile("s_waitcnt vmcnt(0)" ::: "memory");
            const unsigned og = xb_add(&bar[XB_TOP], 1u);
            const unsigned tg = og / nx;
            if (og + 1u == (tg + 1u) * nx) xb_add(&bar[XB_TOPGEN], 1u);
            else XB_SPIN(xb_ld(&bar[XB_TOPGEN]) == tg, bar);
            __builtin_amdgcn_fence(__ATOMIC_ACQUIRE, "agent");
            xb_add(&bar[XB_XGEN(b.x)], 1u);
            asm volatile("s_waitcnt vmcnt(0)" ::: "memory");
        } else {
            XB_SPIN(xb_ld(&bar[XB_XGEN(b.x)]) == gen, bar);
            __builtin_amdgcn_fence(__ATOMIC_ACQUIRE, "agent");
            asm volatile("s_waitcnt vmcnt(0)" ::: "memory");
        }
    }
    __syncthreads();
}

template <bool DA>
__device__ __forceinline__ void attn_unit(LAS unsigned char* lds, const bf16_t* __restrict__ H, int bl, int chunk, int quad, bf16_t* __restrict__ Oout,
                                          const float* __restrict__ biasL, float lam, float oscale, const float* __restrict__ normg) {
    int tid_ = threadIdx.x; asm volatile("" : "+v"(tid_));
    const int tid = tid_, wid = __builtin_amdgcn_readfirstlane(tid >> 6), lane = tid & 63, fr = lane & 15, g = lane >> 4;
    const int hq = wid >> 1, qh = wid & 1;
    constexpr int QCOL = DA ? 4608 : 3072, KCOL = DA ? 5120 : 3584, VCOL = DA ? 5632 : 4096;
    constexpr int RS = 528;
    constexpr int NVB = DA ? 8 : 4;
    LAS unsigned char* Kimg = lds; LAS unsigned char* Vimg = lds + 64 * RS;
    LAS float* biasLds = (LAS float*)(lds + 2 * 64 * RS);
    const size_t rowbase = (size_t)bl * SEQ;
    const int t0 = chunk * 64;
    const int tile_lo = DA ? 0 : (chunk > 8 ? chunk - 8 : 0), tile_hi = chunk;
    __syncthreads();
    bf16x8 qf[2][2];
#pragma unroll
    for (int qb = 0; qb < 2; ++qb)
#pragma unroll
        for (int s = 0; s < 2; ++s) qf[qb][s] = *(const bf16x8*)(H + (rowbase + t0 + qh * 32 + qb * 16 + fr) * HWID + QCOL + quad * 256 + hq * 64 + s * 32 + g * 8);
    if (!DA) { for (int i = tid; i < 4 * 513; i += 512) { const int hh = i / 513, r = i - hh * 513; biasLds[hh * 516 + r] = biasL[(quad * 4 + hh) * 513 + r] * LOG2E; } }
    f32x4 oacc[NVB][2];
#pragma unroll
    for (int vb = 0; vb < NVB; ++vb) { oacc[vb][0] = (f32x4){0.f, 0.f, 0.f, 0.f}; oacc[vb][1] = (f32x4){0.f, 0.f, 0.f, 0.f}; }
    float mrun[2] = {-1e30f, -1e30f}, lrun[2] = {0.f, 0.f};
    u32x4 pk[4], pv[4];
    const int prow = tid >> 5, pc = tid & 31;
    {   const bf16_t* src = H + (rowbase + tile_lo * 64 + prow) * HWID + quad * 256 + pc * 8;
#pragma unroll
        for (int k = 0; k < 4; ++k) { pk[k] = *(const u32x4*)(src + (size_t)k * 16 * HWID + KCOL); pv[k] = *(const u32x4*)(src + (size_t)k * 16 * HWID + VCOL); } }
    const int vcol0 = DA ? (hq >> 1) * 128 : hq * 64;
    for (int tile = tile_lo; tile <= tile_hi; ++tile) {
        __syncthreads();
#pragma unroll
        for (int k = 0; k < 4; ++k) { *(LAS u32x4*)(Kimg + (prow + 16 * k) * RS + pc * 16) = pk[k]; *(LAS u32x4*)(Vimg + (prow + 16 * k) * RS + pc * 16) = pv[k]; }
        __syncthreads();
        if (tile < tile_hi) { const bf16_t* src = H + (rowbase + (tile + 1) * 64 + prow) * HWID + quad * 256 + pc * 8;
#pragma unroll
            for (int k = 0; k < 4; ++k) { pk[k] = *(const u32x4*)(src + (size_t)k * 16 * HWID + KCOL); pv[k] = *(const u32x4*)(src + (size_t)k * 16 * HWID + VCOL); } }
        f32x4 sacc[4][2];
#pragma unroll
        for (int kb = 0; kb < 4; ++kb) { sacc[kb][0] = (f32x4){0.f, 0.f, 0.f, 0.f}; sacc[kb][1] = (f32x4){0.f, 0.f, 0.f, 0.f};
#pragma unroll
            for (int s = 0; s < 2; ++s) { const bf16x8 kf = *(const LAS bf16x8*)(Kimg + (kb * 16 + fr) * RS + (hq * 64 + s * 32 + g * 8) * 2);
                sacc[kb][0] = MFMA16(kf, qf[0][s], sacc[kb][0]); sacc[kb][1] = MFMA16(kf, qf[1][s], sacc[kb][1]); } }
        if (!DA) {
#pragma unroll
            for (int kb = 0; kb < 4; ++kb)
#pragma unroll
                for (int qb = 0; qb < 2; ++qb)
#pragma unroll
                    for (int i = 0; i < 4; ++i) { const int key = tile * 64 + kb * 16 + 4 * g + i, q = t0 + qh * 32 + qb * 16 + fr; int rel = q - key; rel = rel < -256 ? -256 : (rel > 256 ? 256 : rel);
                        sacc[kb][qb][i] += biasLds[hq * 516 + rel + 256]; }
        }
        bf16x8 pf[2][2];
#pragma unroll
        for (int qb = 0; qb < 2; ++qb) {
            float mx = -1e30f;
#pragma unroll
            for (int kb = 0; kb < 4; ++kb)
#pragma unroll
                for (int i = 0; i < 4; ++i) mx = fmaxf(mx, sacc[kb][qb][i]);
            mx = fmaxf(mx, __shfl_xor(mx, 16)); mx = fmaxf(mx, __shfl_xor(mx, 32));
            const float mnew = fmaxf(mrun[qb], mx), alpha = ex2(mrun[qb] - mnew); mrun[qb] = mnew;
            float rs = 0.f;
#pragma unroll
            for (int kb = 0; kb < 4; ++kb)
#pragma unroll
                for (int i = 0; i < 4; ++i) { const float p = ex2(sacc[kb][qb][i] - mnew); sacc[kb][qb][i] = p; rs += p; }
            rs += __shfl_xor(rs, 16); rs += __shfl_xor(rs, 32);
            lrun[qb] = lrun[qb] * alpha + rs;
#pragma unroll
            for (int vb = 0; vb < NVB; ++vb) oacc[vb][qb] = oacc[vb][qb] * alpha;
            pf[qb][0] = pack8(sacc[0][qb], sacc[1][qb]); pf[qb][1] = pack8(sacc[2][qb], sacc[3][qb]);
        }
#pragma unroll
        for (int vb = 0; vb < NVB; ++vb)
#pragma unroll
            for (int s2 = 0; s2 < 2; ++s2) {
                const s16x4 lo = tr_read(Vimg + (32 * s2 + 4 * g + (fr >> 2)) * RS + (vcol0 + 16 * vb + 4 * (fr & 3)) * 2);
                const s16x4 hi = tr_read(Vimg + (32 * s2 + 16 + 4 * g + (fr >> 2)) * RS + (vcol0 + 16 * vb + 4 * (fr & 3)) * 2);
                const bf16x8 vf = cat8(lo, hi);
                oacc[vb][0] = MFMA16(vf, pf[0][s2], oacc[vb][0]); oacc[vb][1] = MFMA16(vf, pf[1][s2], oacc[vb][1]); }
    }
    const float inv0 = 1.0f / lrun[0], inv1 = 1.0f / lrun[1];
    if (!DA) {
#pragma unroll
        for (int qb = 0; qb < 2; ++qb) { const float inv = qb ? inv1 : inv0; bf16_t* dst = Oout + (rowbase + t0 + qh * 32 + qb * 16 + fr) * 512 + (quad * 4 + hq) * 64 + 4 * g;
#pragma unroll
            for (int vb = 0; vb < NVB; ++vb) { const f32x4 o = oacc[vb][qb] * inv; u32x2 w; w.x = cvt_pk_bf16(o[0], o[1]); w.y = cvt_pk_bf16(o[2], o[3]); *(u32x2*)(dst + 16 * vb) = w; } }
    } else {
        __syncthreads();
        LAS float* ex = (LAS float*)lds + ((hq >> 1) * 2 + qh) * 4096 + lane;
        if (hq & 1) {
#pragma unroll
            for (int vb = 0; vb < NVB; ++vb)
#pragma unroll
                for (int qb = 0; qb < 2; ++qb)
#pragma unroll
                    for (int i = 0; i < 4; ++i) ex[((vb * 2 + qb) * 4 + i) * 64] = oacc[vb][qb][i] * (qb ? inv1 : inv0);
        }
        __syncthreads();
        if (!(hq & 1)) {
#pragma unroll
            for (int qb = 0; qb < 2; ++qb) { const float inv = qb ? inv1 : inv0; float ss = 0.f;
#pragma unroll
                for (int vb = 0; vb < NVB; ++vb)
#pragma unroll
                    for (int i = 0; i < 4; ++i) { const float o = oacc[vb][qb][i] * inv - lam * ex[((vb * 2 + qb) * 4 + i) * 64]; oacc[vb][qb][i] = o; ss += o * o; }
                ss += __shfl_xor(ss, 16); ss += __shfl_xor(ss, 32);
                const float r = oscale / sqrtf(ss * (1.0f / 128.0f) + LN_EPS);
                bf16_t* dst = Oout + (rowbase + t0 + qh * 32 + qb * 16 + fr) * 512 + (quad * 2 + (hq >> 1)) * 128 + 4 * g;
#pragma unroll
                for (int vb = 0; vb < NVB; ++vb) { const f32x4 ng = *(const f32x4*)(normg + 16 * vb + 4 * g); const f32x4 o = oacc[vb][qb] * ng * r;
                    u32x2 w; w.x = cvt_pk_bf16(o[0], o[1]); w.y = cvt_pk_bf16(o[2], o[3]); *(u32x2*)(dst + 16 * vb) = w; } }
        }
    }
}

__device__ __forceinline__ void ret_unit(LAS unsigned char* lds, const bf16_t* __restrict__ H, int bl, int h, bf16_t* __restrict__ OA, const float* __restrict__ normg) {
    int tid_ = threadIdx.x; asm volatile("" : "+v"(tid_));
    const int tid = tid_, wid = __builtin_amdgcn_readfirstlane(tid >> 6), lane = tid & 63, fr = lane & 15, g = lane >> 4;
    constexpr int QS = 272, VS = 528, PS = 144;
    LAS unsigned char* Qimg = lds; LAS unsigned char* Kimg = lds + 64 * QS; LAS unsigned char* K2img = lds + 2 * 64 * QS; LAS unsigned char* Vimg = lds + 3 * 64 * QS;
    LAS unsigned char* Pimg = Vimg + 64 * VS; LAS float* part = (LAS float*)(Pimg + 64 * PS);
    const float lg2 = log2f(1.0f - ex2(-5.0f - (float)h));
    const float cd = ex2(lg2 * 64.0f);
    const size_t rowbase = (size_t)bl * SEQ;
    f32x4 st[8][2];
#pragma unroll
    for (int db = 0; db < 8; ++db) { st[db][0] = (f32x4){0.f, 0.f, 0.f, 0.f}; st[db][1] = (f32x4){0.f, 0.f, 0.f, 0.f}; }
    const int qrow = tid >> 4, qc = tid & 15;
    const int vrow = tid >> 5, vc = tid & 31;
    const int rb1 = wid >> 1, ch1 = wid & 1;
    const float ng0 = normg[32 * wid + fr], ng1 = normg[32 * wid + 16 + fr];
    u32x4 pq[2], pk[2], pv[4];
    {   const bf16_t* src = H + rowbase * HWID;
#pragma unroll
        for (int k = 0; k < 2; ++k) { const int r = qrow + 32 * k; pq[k] = *(const u32x4*)(src + (size_t)r * HWID + h * 128 + qc * 8); pk[k] = *(const u32x4*)(src + (size_t)r * HWID + 512 + h * 128 + qc * 8); }
#pragma unroll
        for (int k = 0; k < 4; ++k) pv[k] = *(const u32x4*)(src + (size_t)(vrow + 16 * k) * HWID + 1024 + h * 256 + vc * 8); }
    for (int c = 0; c < 32; ++c) {
        int tl = tid_; asm volatile("" : "+v"(tl));
        const int lane = tl & 63, fr = lane & 15, g = lane >> 4, qrow = tl >> 4, qc = tl & 15, vrow = tl >> 5, vc = tl & 31;
        float lgc = lg2; asm volatile("" : "+v"(lgc));
        __syncthreads();
#pragma unroll
        for (int k = 0; k < 2; ++k) { const int r = qrow + 32 * k;
            *(LAS u32x4*)(Qimg + r * QS + qc * 16) = pq[k]; *(LAS u32x4*)(Kimg + r * QS + qc * 16) = pk[k];
            f32x4 a, b; pg8::unpack8(pk[k], a, b); const float kd = ex2(lgc * (float)(63 - r)); *(LAS bf16x8*)(K2img + r * QS + qc * 16) = pack8(a * kd, b * kd); }
#pragma unroll
        for (int k = 0; k < 4; ++k) *(LAS u32x4*)(Vimg + (vrow + 16 * k) * VS + vc * 16) = pv[k];
        __syncthreads();
        {   f32x4 pa[2] = {(f32x4){0.f, 0.f, 0.f, 0.f}, (f32x4){0.f, 0.f, 0.f, 0.f}};
#pragma unroll
            for (int s = 0; s < 4; ++s) { const bf16x8 qa = *(const LAS bf16x8*)(Qimg + (16 * rb1 + fr) * QS + (32 * s + 8 * g) * 2);
#pragma unroll
                for (int cb = 0; cb < 2; ++cb) { const bf16x8 kbf = *(const LAS bf16x8*)(Kimg + (32 * ch1 + 16 * cb + fr) * QS + (32 * s + 8 * g) * 2); pa[cb] = MFMA16(qa, kbf, pa[cb]); } }
#pragma unroll
            for (int cb = 0; cb < 2; ++cb)
#pragma unroll
                for (int i = 0; i < 4; ++i) { const int n = 16 * rb1 + 4 * g + i, m = 32 * ch1 + 16 * cb + fr; const int d = n > m ? n - m : m - n;
                    *(LAS unsigned short*)(Pimg + n * PS + m * 2) = (unsigned short)f2bf(pa[cb][i] * ex2(lgc * (float)d)); } }
        __syncthreads();
        bf16x8 vfr[2][2];
#pragma unroll
        for (int cb = 0; cb < 2; ++cb)
#pragma unroll
            for (int s2 = 0; s2 < 2; ++s2) { const s16x4 lo = tr_read(Vimg + (32 * s2 + 8 * g + (fr >> 2)) * VS + (32 * wid + 16 * cb + 4 * (fr & 3)) * 2);
                const s16x4 hi = tr_read(Vimg + (32 * s2 + 8 * g + 4 + (fr >> 2)) * VS + (32 * wid + 16 * cb + 4 * (fr & 3)) * 2); vfr[cb][s2] = cat8(lo, hi); }
        f32x4 oa[4][2];
#pragma unroll
        for (int rb = 0; rb < 4; ++rb) { oa[rb][0] = (f32x4){0.f, 0.f, 0.f, 0.f}; oa[rb][1] = (f32x4){0.f, 0.f, 0.f, 0.f}; }
#pragma unroll
        for (int s = 0; s < 4; ++s) { const bf16x8 sb0 = pack8(st[2 * s][0], st[2 * s + 1][0]), sb1 = pack8(st[2 * s][1], st[2 * s + 1][1]);
#pragma unroll
            for (int rb = 0; rb < 4; ++rb) { const s16x4 lo = *(const LAS s16x4*)(Qimg + (16 * rb + fr) * QS + (32 * s + 4 * g) * 2), hi = *(const LAS s16x4*)(Qimg + (16 * rb + fr) * QS + (32 * s + 16 + 4 * g) * 2);
                const bf16x8 qa = cat8(lo, hi); oa[rb][0] = MFMA16(qa, sb0, oa[rb][0]); oa[rb][1] = MFMA16(qa, sb1, oa[rb][1]); } }
#pragma unroll
        for (int rb = 0; rb < 4; ++rb)
#pragma unroll
            for (int i = 0; i < 4; ++i) { const float qd = ex2(lgc * (float)(16 * rb + 4 * g + i + 1)); oa[rb][0][i] *= qd; oa[rb][1][i] *= qd; }
#pragma unroll
        for (int rb = 0; rb < 4; ++rb)
#pragma unroll
            for (int s2 = 0; s2 < 2; ++s2) { const bf16x8 pa = *(const LAS bf16x8*)(Pimg + (16 * rb + fr) * PS + (32 * s2 + 8 * g) * 2);
                oa[rb][0] = MFMA16(pa, vfr[0][s2], oa[rb][0]); oa[rb][1] = MFMA16(pa, vfr[1][s2], oa[rb][1]); }
#pragma unroll
        for (int db = 0; db < 8; ++db) { st[db][0] = st[db][0] * cd; st[db][1] = st[db][1] * cd;
#pragma unroll
            for (int s2 = 0; s2 < 2; ++s2) { const s16x4 lo = tr_read(K2img + (32 * s2 + 8 * g + (fr >> 2)) * QS + (16 * db + 4 * (fr & 3)) * 2);
                const s16x4 hi = tr_read(K2img + (32 * s2 + 8 * g + 4 + (fr >> 2)) * QS + (16 * db + 4 * (fr & 3)) * 2); const bf16x8 ka = cat8(lo, hi);
                st[db][0] = MFMA16(ka, vfr[0][s2], st[db][0]); st[db][1] = MFMA16(ka, vfr[1][s2], st[db][1]); } }
        if (c < 31) { const bf16_t* src = H + (rowbase + (c + 1) * 64) * HWID;
#pragma unroll
            for (int k = 0; k < 2; ++k) { const int r = qrow + 32 * k; pq[k] = *(const u32x4*)(src + (size_t)r * HWID + h * 128 + qc * 8); pk[k] = *(const u32x4*)(src + (size_t)r * HWID + 512 + h * 128 + qc * 8); }
#pragma unroll
            for (int k = 0; k < 4; ++k) pv[k] = *(const u32x4*)(src + (size_t)(vrow + 16 * k) * HWID + 1024 + h * 256 + vc * 8); }
#pragma unroll
        for (int rb = 0; rb < 4; ++rb)
#pragma unroll
            for (int i = 0; i < 4; ++i) { float ss = oa[rb][0][i] * oa[rb][0][i] + oa[rb][1][i] * oa[rb][1][i];
                ss += __shfl_xor(ss, 1); ss += __shfl_xor(ss, 2); ss += __shfl_xor(ss, 4); ss += __shfl_xor(ss, 8);
                if (fr == 0) part[wid * 64 + 16 * rb + 4 * g + i] = ss; }
        u32x4 gt[4];
#pragma unroll
        for (int k = 0; k < 4; ++k) gt[k] = *(const u32x4*)(H + (rowbase + c * 64 + vrow + 16 * k) * HWID + 2048 + h * 256 + vc * 8);
        __syncthreads();
#pragma unroll
        for (int rb = 0; rb < 4; ++rb)
#pragma unroll
            for (int i = 0; i < 4; ++i) { const int n = 16 * rb + 4 * g + i; float tot = 0.f;
#pragma unroll
                for (int w = 0; w < 8; ++w) tot += part[w * 64 + n];
                const float r = 1.0f / sqrtf(tot * (1.0f / 256.0f) + LN_EPS);
                *(LAS unsigned short*)(Vimg + n * VS + (32 * wid + fr) * 2) = (unsigned short)f2bf(oa[rb][0][i] * r * ng0);
                *(LAS unsigned short*)(Vimg + n * VS + (32 * wid + 16 + fr) * 2) = (unsigned short)f2bf(oa[rb][1][i] * r * ng1); }
        __syncthreads();
#pragma unroll
        for (int k = 0; k < 4; ++k) { const int r = vrow + 16 * k; const u32x4 ov = *(const LAS u32x4*)(Vimg + r * VS + vc * 16);
            f32x4 o0, o1, g0, g1; pg8::unpack8(ov, o0, o1); pg8::unpack8(gt[k], g0, g1);
            *(bf16x8*)(OA + (rowbase + c * 64 + r) * 1024 + h * 256 + vc * 8) = pack8(o0 * g0, o1 * g1); }
    }
}

__global__ void __launch_bounds__(512, 2) fwd_kernel(Params P) {
    extern __shared__ __attribute__((aligned(16))) unsigned char lds_raw[];
    LAS unsigned char* lds = (LAS unsigned char*)lds_raw;
    cg::grid_group grid = cg::this_grid();
    const int tid = threadIdx.x, lane = tid & 63, wave = __builtin_amdgcn_readfirstlane(tid >> 6);
    const int NB = gridDim.x, bid = blockIdx.x;
    const int gw = bid * 8 + wave, NGW = NB * 8;
    unsigned char* ws = P.ws;
    const int G = P.G, Mg = G * SEQ, ngrp = NSEQ / G;
    float* tabR = (float*)(ws + WS_TABR); float* tabD = (float*)(ws + WS_TABD);
    bf16_t* WinT = (bf16_t*)(ws + WS_WIN); bf16_t* WaT = (bf16_t*)(ws + WS_WA); bf16_t* WbT = (bf16_t*)(ws + WS_WB); bf16_t* WcT = (bf16_t*)(ws + WS_WC);
    bf16_t* WoT = (bf16_t*)(ws + WS_WO); bf16_t* WfiT = (bf16_t*)(ws + WS_WFI); bf16_t* WfoT = (bf16_t*)(ws + WS_WFO);
    bf16_t* XB = (bf16_t*)(ws + WS_ACT); bf16_t* Hb = XB + (size_t)Mg * 1024; bf16_t* OA = Hb + (size_t)Mg * HWID; bf16_t* OB = OA + (size_t)Mg * 1024; bf16_t* OC = OB + (size_t)Mg * 512;
    bf16_t* ACT = Hb;
    unsigned* qcnt = (unsigned*)(ws + WS_CTL);
    {   volatile LAS unsigned* bst = (volatile LAS unsigned*)(lds + QSLOT_OFF + 64); if (tid < 2) bst[tid] = 0u; }
    __syncthreads();
    const XcdBarrier xbar = xcd_barrier_post((unsigned*)(ws + WS_CTL + 8192), (volatile LAS unsigned*)(lds + QSLOT_OFF + 64));
#define GSYNC() xcd_barrier(xbar)

    {
        LAS float* scr = (LAS float*)(lds + wave * 16384);
        constexpr int I_IN = 16 * 288, I_A = 16 * 32, I_B = 8 * 32, I_C = 8 * 32, I_O = 16 * 32, I_FI = 16 * 176, I_FO = 44 * 32;
        constexpr int I_L = I_IN + I_A + I_B + I_C + I_O + I_FI + I_FO;
        for (int it = gw; it < DEPTH * I_L; it += NGW) {
            const int l = it / I_L; int r = it - l * I_L;
            if (r < I_IN) { const int kb = r / 288, n0 = 32 * (r % 288); transpose_item(P.in[1] + (size_t)l * 1024 * HWID, 1024, HWID, WinT + (size_t)l * HWID * 1024, scr, kb, n0, map_in(n0), lane); continue; } r -= I_IN;
            if (r < I_A) { const int kb = r / 32, n0 = 32 * (r % 32); transpose_item(P.in[9] + (size_t)l * 1024 * 1024, 1024, 1024, WaT + (size_t)l * 1024 * 1024, scr, kb, n0, n0, lane); continue; } r -= I_A;
            if (r < I_B) { const int kb = r / 32, n0 = 32 * (r % 32); transpose_item(P.in[10] + (size_t)l * 512 * 1024, 512, 1024, WbT + (size_t)l * 1024 * 512, scr, kb, n0, n0, lane); continue; } r -= I_B;
            if (r < I_C) { const int kb = r / 32, n0 = 32 * (r % 32); transpose_item(P.in[11] + (size_t)l * 512 * 1024, 512, 1024, WcT + (size_t)l * 1024 * 512, scr, kb, n0, n0, lane); continue; } r -= I_C;
            if (r < I_O) { const int kb = r / 32, n0 = 32 * (r % 32); transpose_item(P.in[13] + (size_t)l * 1024 * 1024, 1024, 1024, WoT + (size_t)l * 1024 * 1024, scr, kb, n0, n0, lane); continue; } r -= I_O;
            if (r < I_FI) { const int kb = r / 176, n0 = 32 * (r % 176); transpose_item(P.in[16] + (size_t)l * 1024 * 2 * FFH, 1024, 2 * FFH, WfiT + (size_t)l * 2 * FFH * 1024, scr, kb, n0, map_ffn(n0), lane); continue; } r -= I_FI;
            { const int kb = r / 32, n0 = 32 * (r % 32); transpose_item(P.in[17] + (size_t)l * FFH * 1024, FFH, 1024, WfoT + (size_t)l * 1024 * FFH, scr, kb, n0, n0, lane); }
        }
        for (int i = bid * 512 + tid; i < SEQ * 96; i += NB * 512) {
            int pos, j; float invf; float* cdst; float* sdst;
            if (i < SEQ * 64) { pos = i >> 6; j = i & 63; invf = powf(10000.0f, -(float)(2 * j) / 128.0f); cdst = tabR + i; sdst = tabR + SEQ * 64 + i; }
            else { const int i2 = i - SEQ * 64; pos = i2 >> 5; j = i2 & 31; invf = powf(10000.0f, -(float)(2 * j) / 64.0f); cdst = tabD + i2; sdst = tabD + SEQ * 32 + i2; }
            const float ang = (float)pos * invf;
            const double rev = (double)ang * 0.15915494309189535; const float fr_ = (float)(rev - floor(rev));
            *cdst = __builtin_amdgcn_cosf(fr_); *sdst = __builtin_amdgcn_sinf(fr_);
        }
    }
    grid.sync();

    for (int grp = 0; grp < ngrp; ++grp) {
        const size_t goff = (size_t)grp * Mg * 1024;
        float* X = P.out + goff;
        {   const f32x4* src = (const f32x4*)(P.in[0] + goff); u32x2* dst = (u32x2*)XB; int t_ = tid; asm volatile("" : "+v"(t_));
            for (size_t i = (size_t)bid * 512 + t_; i < (size_t)Mg * 256; i += (size_t)NB * 512) { const f32x4 v = src[i]; u32x2 w; w.x = cvt_pk_bf16(v[0], v[1]); w.y = cvt_pk_bf16(v[2], v[3]); dst[i] = w; } }
        GSYNC();
        for (int l = 0; l < DEPTH; ++l) {
            for (int half = 0; half < 2; ++half) {
                if (half == 0) {
                    {   pg8::Gemm gm{XB, WinT + (size_t)l * HWID * 1024, Mg, HWID, 1024}; pg8::StaticOrder S; S.init(Mg, HWID, NB, bid);
                        pg8::EpiIn E{Hb, P.in[12] + l * 3072, tabR, tabD};

#ifndef NO_G1
pg8::gemm_phase<pg8::EpiIn, pg8::StaticOrder, true, true>(lds, gm, S, E);
#endif
 }
#ifdef PROBE_G1X2
                    {   pg8::Gemm gm{XB, WinT + (size_t)l * HWID * 1024, Mg, HWID, 1024}; pg8::StaticOrder S; S.init(Mg, HWID, NB, bid);
                        pg8::EpiIn E{Hb, P.in[12] + l * 3072, tabR, tabD};
                        pg8::gemm_phase<pg8::EpiIn, pg8::StaticOrder, true, true>(lds, gm, S, E); }
#endif
#ifdef PROBE_SYNC8
                    for (int z = 0; z < 8; ++z) GSYNC();
#endif
                    GSYNC();
#ifdef PROBE_MIX2
                    for (int rep = 0; rep < 2; ++rep)
#else
                    const int rep = 0;
#endif
                    {   const float lambda_init = 0.8f - 0.6f * expf(-0.3f * (float)l);
                        float d1 = 0.f, d2 = 0.f;
                        for (int i = 0; i < 64; ++i) { d1 += P.in[4][l * 64 + i] * P.in[5][l * 64 + i]; d2 += P.in[6][l * 64 + i] * P.in[7][l * 64 + i]; }
                        const float lam = expf(d1) - expf(d2) + lambda_init;
                        const int NR = G * 4, NDA = G * 64, NU = NR + 2 * NDA;
                        volatile LAS int* qslot = (volatile LAS int*)(lds + QSLOT_OFF);
                        for (;;) {
                            __syncthreads();
                            if (tid == 0) *qslot = (int)atomicAdd(qcnt + rep * 64 + grp * DEPTH + l, 1u);
                            __syncthreads();
                            const int u = *qslot;
                            if (u >= NU) break;
                            if (u < NR) {
#ifndef NO_RET
 ret_unit(lds, Hb, u >> 2, u & 3, OA, P.in[2] + l * 256);
#endif
#ifdef PROBE_RET2
 ret_unit(lds, Hb, u >> 2, u & 3, OA, P.in[2] + l * 256);
#endif
 }
                            else if (u < NR + NDA) { const int v = u - NR; const int chunk = 31 - v / (2 * G), rem = v % (2 * G);
#ifndef NO_DA
 attn_unit<true>(lds, Hb, rem >> 1, chunk, rem & 1, OC, nullptr, lam, 1.0f - lambda_init, P.in[8] + l * 128);
#endif
 }
                            else { const int v = u - NR - NDA; const int chunk = 31 - v / (2 * G), rem = v % (2 * G);
#ifndef NO_CA
 attn_unit<false>(lds, Hb, rem >> 1, chunk, rem & 1, OB, P.in[3] + l * 8 * 513, 0.f, 1.f, nullptr);
#endif
 }
                        }
#ifdef PROBE_MIX2
                        GSYNC();
#endif
                    }
#ifndef PROBE_MIX2
                    GSYNC();
#endif
                    for (int br = 0; br < 3; ++br) {
                        const bf16_t* A = br == 0 ? OA : (br == 1 ? OB : OC); const int K = br == 0 ? 1024 : 512;
                        const bf16_t* Bt = br == 0 ? WaT + (size_t)l * 1024 * 1024 : (br == 1 ? WbT + (size_t)l * 1024 * 512 : WcT + (size_t)l * 1024 * 512);
                        pg8::Gemm gm{A, Bt, Mg, 1024, K}; pg8::StaticOrder S; S.init(Mg, 1024, NB, bid);
                        pg8::EpiBranch E{XB, Hb, br, br == 0};

#ifndef NO_G3
pg8::gemm_phase<pg8::EpiBranch, pg8::StaticOrder, true, true>(lds, gm, S, E);
#endif

                    }
                    GSYNC();
                } else {
                    {   pg8::Gemm gm{XB, WfiT + (size_t)l * 2 * FFH * 1024, Mg, 2 * FFH, 1024}; pg8::StaticOrder S; S.init(Mg, 2 * FFH, NB, bid);
                        pg8::EpiSwiglu E{ACT};

#ifndef NO_G5
pg8::gemm_phase<pg8::EpiSwiglu, pg8::StaticOrder, true, true>(lds, gm, S, E);
#endif
 }
                    GSYNC();
                }
                {   const bf16_t* A = half == 0 ? XB : ACT; const int K = half == 0 ? 1024 : FFH;
                    const bf16_t* Bt = half == 0 ? WoT + (size_t)l * 1024 * 1024 : WfoT + (size_t)l * 1024 * FFH;
                    const float* resid = (half == 0 && l == 0) ? P.in[0] + goff : X;
                    pg8::Gemm gm{A, Bt, Mg, 1024, K}; pg8::StaticOrder S; S.init(Mg, 1024, NB, bid);
                    pg8::EpiResid E{resid, X, ALPHA};

#ifndef NO_G4
pg8::gemm_phase<pg8::EpiResid, pg8::StaticOrder, true, true>(lds, gm, S, E);
#endif
 }
                GSYNC();
                {   const float* gam = (half == 0 ? P.in[14] : P.in[18]) + l * 1024; const float* bet = (half == 0 ? P.in[15] : P.in[19]) + l * 1024;
                    f32x4 gv[4], bv[4]; int lane_ = lane; asm volatile("" : "+v"(lane_));
#define lane lane_
#pragma unroll
                    for (int j = 0; j < 4; ++j) { gv[j] = *((const f32x4*)gam + lane + 64 * j); bv[j] = *((const f32x4*)bet + lane + 64 * j); }
                    for (int m = gw; m < Mg; m += NGW) {
                        f32x4* xr = (f32x4*)(X + (size_t)m * 1024) + lane; f32x4 v[4]; float s = 0.f;
#pragma unroll
                        for (int j = 0; j < 4; ++j) { v[j] = xr[64 * j]; s += (v[j][0] + v[j][1]) + (v[j][2] + v[j][3]); }
                        const float mean = wave_sum(s) * (1.0f / 1024.0f); float s2 = 0.f;
#pragma unroll
                        for (int j = 0; j < 4; ++j) { v[j] = v[j] - mean; s2 += (v[j][0] * v[j][0] + v[j][1] * v[j][1]) + (v[j][2] * v[j][2] + v[j][3] * v[j][3]); }
                        const float rstd = 1.0f / sqrtf(wave_sum(s2) * (1.0f / 1024.0f) + LN_EPS);
                        u32x2* o8 = (u32x2*)(XB + (size_t)m * 1024) + lane;
#pragma unroll
                        for (int j = 0; j < 4; ++j) { const f32x4 y = v[j] * rstd * gv[j] + bv[j]; xr[64 * j] = y; u32x2 w; w.x = cvt_pk_bf16(y[0], y[1]); w.y = cvt_pk_bf16(y[2], y[3]); o8[64 * j] = w; }
                    }
#undef lane
                }
                GSYNC();
            }
        }
    }
}

extern "C" void kernel_launch(void* const* d_in, const int* in_sizes, int n_in, void* d_out, int out_size, void* d_ws, size_t ws_size, hipStream_t stream) {
    static int grid_blocks = 0;
    if (grid_blocks == 0) {
        int dev = 0, cus = 0, per_cu = 0;
        hipGetDevice(&dev); hipDeviceGetAttribute(&cus, hipDeviceAttributeMultiprocessorCount, dev);
        hipFuncSetAttribute((const void*)fwd_kernel, hipFuncAttributeMaxDynamicSharedMemorySize, LDS_BYTES);
        hipOccupancyMaxActiveBlocksPerMultiprocessor(&per_cu, (const void*)fwd_kernel, 512, LDS_BYTES);
        if (per_cu < 1) per_cu = 1;
        grid_blocks = cus;
        (void)hipGetLastError();
    }
    int G = 16;
    while (G > 1 && WS_ACT + (size_t)G * SEQ * 24576 > ws_size) G >>= 1;
    hipMemsetAsync(d_ws, 0, 65536, stream);
    Params p{};
    for (int i = 0; i < 20; ++i) p.in[i] = (const float*)d_in[i];
    p.out = (float*)d_out; p.ws = (unsigned char*)d_ws; p.G = G; p.pad = 0;
    void* args[] = {&p};
    hipError_t e = hipLaunchCooperativeKernel((const void*)fwd_kernel, dim3(grid_blocks), dim3(512), args, LDS_BYTES, stream);
    if (e != hipSuccess) fprintf(stderr, "cooperative launch failed: %s (grid %d)\n", hipGetErrorString(e), grid_blocks);
}
```
